# Optimizing an MI355X kernel written in HIP

```python
import jax
import jax.numpy as jnp
from jax import lax
import numpy as np

D_MODEL = 1024
BATCH = 8
SEQ = 2048
DEPTH = 2
DEC_BATCH = 128
DEC_SEQ = 1
PAST_LEN = 16384
PAGE_SIZE = 128

N_AB_LAYERS = (DEPTH + 1) // 2
N_C_LAYERS = DEPTH // 2
POOL_WINDOWS = (2, 4, 8, 16)
POOL_GROUPS = len(POOL_WINDOWS)
POOL_GROUP_WIDTH = D_MODEL // 8
POOL_WIDTH = POOL_GROUPS * POOL_GROUP_WIDTH
POOL_BUF = max(POOL_WINDOWS) - 1
RWKV_HEAD = 64
RWKV_WIDTH = D_MODEL // 2
RWKV_HEADS = RWKV_WIDTH // RWKV_HEAD
W_LORA = 64
A_LORA = 64
G_LORA = 128
RWKV_IN = 3 * RWKV_WIDTH + W_LORA + A_LORA + G_LORA
AB_IN = POOL_WIDTH + RWKV_IN
AB_OUT = POOL_WIDTH + RWKV_WIDTH
CHUNK = 128
SGU_WIDTH = 2 * D_MODEL
SGU_GROUPS = 4
MEM_LEN = 256
XA_HEADS = 4
XA_HEAD_DIM = D_MODEL // XA_HEADS
D_FF = 4 * D_MODEL
RMS_EPS = 1e-5
LN_EPS = 1e-5
GN_EPS = RWKV_HEAD * 1e-5
L2_EPS = 1e-12

kernel_name = 'hybrid_pool_rwkv7_gmlp_memxattn_step'


def rmsnorm(x, g):
    xf = x.astype(jnp.float32)
    y = xf * lax.rsqrt(jnp.mean(xf * xf, axis=-1, keepdims=True) + RMS_EPS)
    return (y * g).astype(x.dtype)


def layernorm(x, g, b):
    xf = x.astype(jnp.float32)
    m = jnp.mean(xf, axis=-1, keepdims=True)
    var = jnp.mean(jnp.square(xf - m), axis=-1, keepdims=True)
    return ((xf - m) * lax.rsqrt(var + LN_EPS) * g + b).astype(x.dtype)


def pool_mix(z, buf, pos0, w_group, scale):
    b, l, _ = z.shape
    full = jnp.concatenate([buf.astype(z.dtype), z], axis=1)
    cs = jnp.cumsum(full.astype(jnp.float32), axis=1)
    cs = jnp.concatenate([jnp.zeros((b, 1, POOL_WIDTH), jnp.float32), cs], axis=1)
    pos = pos0 + jnp.arange(l, dtype=jnp.int32)
    hi = cs[:, POOL_BUF + 1:POOL_BUF + 1 + l]
    pooled = []
    for gi, win in enumerate(POOL_WINDOWS):
        cols = slice(gi * POOL_GROUP_WIDTH, (gi + 1) * POOL_GROUP_WIDTH)
        lo = cs[:, POOL_BUF + 1 - win:POOL_BUF + 1 - win + l, cols]
        count = jnp.minimum(pos + 1, win).astype(jnp.float32)[None, :, None]
        pooled.append((hi[..., cols] - lo) / count)
    d = jnp.concatenate(pooled, axis=-1) - z.astype(jnp.float32)
    d = d.reshape(b, l, POOL_GROUPS, POOL_GROUP_WIDTH)
    y = jnp.einsum('blgc,gcd->blgd', d, w_group.astype(jnp.float32)).reshape(b, l, POOL_WIDTH) * scale
    return y.astype(z.dtype), full[:, -POOL_BUF:]


def rwkv7_mix(z, prev, s0, mu, w0, w2, a0, a2, g2, k_k, k_a, r_k, gn_g, gn_b):
    b, l, _ = z.shape
    zf = z.astype(jnp.float32)
    shifted = jnp.concatenate([prev.astype(jnp.float32)[:, None], zf[:, :-1]], axis=1)
    zs = zf + (shifted - zf) * mu
    w = RWKV_WIDTH
    r, k, v, wl, al, gl = jnp.split(zs, [w, 2 * w, 3 * w, 3 * w + W_LORA, 3 * w + W_LORA + A_LORA], axis=-1)
    wlog = -jax.nn.softplus(-(w0 + jnp.tanh(wl) @ w2)) - 0.5
    decay = jnp.exp(-jnp.exp(wlog))
    a = jax.nn.sigmoid(a0 + al @ a2)
    g = jax.nn.sigmoid(gl) @ g2
    kk = k * k_k
    k = k * (1.0 + (a - 1.0) * k_a)

    def heads(t):
        return t.reshape(b, l, RWKV_HEADS, RWKV_HEAD)

    rh, kh, vh, dh, ah, kkh = heads(r), heads(k), heads(v), heads(decay), heads(a), heads(kk)
    kkh = kkh / jnp.maximum(jnp.sqrt(jnp.sum(kkh * kkh, axis=-1, keepdims=True)), L2_EPS)

    def step(s, inp):
        r_t, k_t, v_t, d_t, kk_t, a_t = inp
        sa = jnp.einsum('bhvk,bhk->bhv', s, -kk_t)
        s = (s * d_t[:, :, None, :] + sa[..., None] * (kk_t * a_t)[:, :, None, :]
             + v_t[..., None] * k_t[:, :, None, :])
        return s, jnp.einsum('bhvk,bhk->bhv', s, r_t)

    xs = tuple(jnp.moveaxis(t, 1, 0) for t in (rh, kh, vh, dh, kkh, ah))
    s_last, ys = lax.scan(step, s0.astype(jnp.float32), xs)
    y = jnp.moveaxis(ys, 0, 1)
    m = jnp.mean(y, axis=-1, keepdims=True)
    var = jnp.mean(jnp.square(y - m), axis=-1, keepdims=True)
    yn = ((y - m) * lax.rsqrt(var + GN_EPS)).reshape(b, l, RWKV_WIDTH) * gn_g + gn_b
    bonus = (jnp.sum(rh * kh * r_k, axis=-1, keepdims=True) * vh).reshape(b, l, RWKV_WIDTH)
    out = (yn + bonus) * g
    return out.astype(z.dtype), z[:, -1], s_last.astype(s0.dtype)


def chunk_spatial(v, w_s, b_s):
    b, l, e = v.shape
    blk = min(l, CHUNK)
    n = -(-l // blk)
    lp = n * blk
    vp = jnp.pad(v, ((0, 0), (0, lp - l), (0, 0))).reshape(b, n, blk, SGU_GROUPS, e // SGU_GROUPS)
    wm = jnp.tril(w_s[:, :blk, :blk])
    out = jnp.einsum('gij,bcjgd->bcigd', wm, vp) + jnp.transpose(b_s[:, :blk])[None, None, :, :, None]
    return out.reshape(b, lp, e)[:, :l]


def sgu_mix(h, w_in, ln_g, ln_b, w_s, b_s, w_out):
    zc = jax.nn.gelu(h @ w_in, approximate=False)
    u, v = jnp.split(zc, 2, axis=-1)
    v = layernorm(v, ln_g, ln_b)
    return (u * chunk_spatial(v, w_s, b_s)) @ w_out, v


def memory_kv(mem, g, w_k, w_v):
    b, m, _ = mem.shape
    mn = rmsnorm(mem, g)
    return ((mn @ w_k).reshape(b, m, XA_HEADS, XA_HEAD_DIM),
            (mn @ w_v).reshape(b, m, XA_HEADS, XA_HEAD_DIM))


def cross_attn(h, k, v, w_q, w_o):
    b, l, _ = h.shape
    q = (h @ w_q).reshape(b, l, XA_HEADS, XA_HEAD_DIM)
    s = jnp.einsum('blhd,bmhd->bhlm', q, k.astype(q.dtype)).astype(jnp.float32) * (XA_HEAD_DIM ** -0.5)
    p = jax.nn.softmax(s, axis=-1).astype(q.dtype)
    o = jnp.einsum('bhlm,bmhd->blhd', p, v.astype(q.dtype)).reshape(b, l, D_MODEL)
    return o @ w_o


def sq_relu_mlp(h, w_up, w_down):
    return jnp.square(jax.nn.relu(h @ w_up)) @ w_down


def setup_inputs(seed: int = 0) -> dict:
    key = jax.random.key(seed)
    ks = iter(jax.random.split(key, 48))
    f32 = jnp.float32

    def nrm(shape, scale=1.0):
        return jax.random.normal(next(ks), shape, f32) * scale

    def gain(shape):
        return 1.0 + 0.02 * jax.random.normal(next(ks), shape, f32)

    d = D_MODEL
    return {
        'x_prompt': nrm((BATCH, SEQ, d)),
        'x_sample': nrm((DEC_BATCH, DEC_SEQ, d)),
        'mem_prompt': nrm((BATCH, MEM_LEN, d)),
        'cache_mem_k': nrm((DEPTH, DEC_BATCH, MEM_LEN, XA_HEADS, XA_HEAD_DIM)),
        'cache_mem_v': nrm((DEPTH, DEC_BATCH, MEM_LEN, XA_HEADS, XA_HEAD_DIM)),
        'state_pool': nrm((N_AB_LAYERS, DEC_BATCH, POOL_BUF, POOL_WIDTH)),
        'state_shift': nrm((N_AB_LAYERS, DEC_BATCH, RWKV_IN)),
        'state_wkv': nrm((N_AB_LAYERS, DEC_BATCH, RWKV_HEADS, RWKV_HEAD, RWKV_HEAD)),
        'norm_mix_g': gain((DEPTH, d)),
        'norm_xa_g': gain((DEPTH, d)),
        'norm_mem_g': gain((DEPTH, d)),
        'norm_ffn_g': gain((DEPTH, d)),
        'norm_final_g': gain((d,)),
        'w_in_ab': nrm((N_AB_LAYERS, d, AB_IN), d ** -0.5),
        'w_out_ab': nrm((N_AB_LAYERS, AB_OUT, d), AB_OUT ** -0.5),
        'pool_w': nrm((N_AB_LAYERS, POOL_GROUPS, POOL_GROUP_WIDTH, POOL_GROUP_WIDTH), POOL_GROUP_WIDTH ** -0.5),
        'pool_scale': gain((N_AB_LAYERS, POOL_WIDTH)),
        'rwkv_mu': jax.random.uniform(next(ks), (N_AB_LAYERS, RWKV_IN), f32),
        'rwkv_w0': nrm((N_AB_LAYERS, RWKV_WIDTH), 0.5),
        'rwkv_w2': nrm((N_AB_LAYERS, W_LORA, RWKV_WIDTH), 0.5 * W_LORA ** -0.5),
        'rwkv_a0': nrm((N_AB_LAYERS, RWKV_WIDTH), 0.1),
        'rwkv_a2': nrm((N_AB_LAYERS, A_LORA, RWKV_WIDTH), 0.5 * A_LORA ** -0.5),
        'rwkv_g2': nrm((N_AB_LAYERS, G_LORA, RWKV_WIDTH), G_LORA ** -0.5),
        'rwkv_k_k': 0.85 + nrm((N_AB_LAYERS, RWKV_WIDTH), 0.02),
        'rwkv_k_a': gain((N_AB_LAYERS, RWKV_WIDTH)),
        'rwkv_r_k': nrm((N_AB_LAYERS, RWKV_HEADS, RWKV_HEAD), 0.1),
        'rwkv_gn_g': gain((N_AB_LAYERS, RWKV_WIDTH)),
        'rwkv_gn_b': nrm((N_AB_LAYERS, RWKV_WIDTH), 0.02),
        'w_in_c': nrm((N_C_LAYERS, d, 2 * SGU_WIDTH), d ** -0.5),
        'sgu_ln_g': gain((N_C_LAYERS, SGU_WIDTH)),
        'sgu_ln_b': nrm((N_C_LAYERS, SGU_WIDTH), 0.02),
        'sgu_w_s': nrm((N_C_LAYERS, SGU_GROUPS, CHUNK, CHUNK), CHUNK ** -0.5),
        'sgu_b_s': gain((N_C_LAYERS, SGU_GROUPS, CHUNK)),
        'w_out_c': nrm((N_C_LAYERS, SGU_WIDTH, d), SGU_WIDTH ** -0.5),
        'w_xq': nrm((DEPTH, d, d), d ** -0.5),
        'w_xk': nrm((DEPTH, d, d), d ** -0.5),
        'w_xv': nrm((DEPTH, d, d), d ** -0.5),
        'w_xo': nrm((DEPTH, d, d), d ** -0.5),
        'w_ff_up': nrm((DEPTH, d, D_FF), d ** -0.5),
        'w_ff_down': nrm((DEPTH, D_FF, d), D_FF ** -0.5),
    }


def reference(x_prompt, x_sample, mem_prompt, cache_mem_k, cache_mem_v, state_pool, state_shift, state_wkv,
              norm_mix_g, norm_xa_g, norm_mem_g, norm_ffn_g, norm_final_g,
              w_in_ab, w_out_ab, pool_w, pool_scale,
              rwkv_mu, rwkv_w0, rwkv_w2, rwkv_a0, rwkv_a2, rwkv_g2, rwkv_k_k, rwkv_k_a, rwkv_r_k,
              rwkv_gn_g, rwkv_gn_b,
              w_in_c, sgu_ln_g, sgu_ln_b, sgu_w_s, sgu_b_s, w_out_c,
              w_xq, w_xk, w_xv, w_xo, w_ff_up, w_ff_down):

    def trunk(x, pos0, mem_k, mem_v, pool_in, shift_in, wkv_in):
        pool_out, shift_out, wkv_out, sgu_v_out = [], [], [], []
        for l in range(DEPTH):
            j = l // 2
            h = rmsnorm(x, norm_mix_g[l])
            if l % 2 == 0:
                z = h @ w_in_ab[j]
                y_pool, pool_new = pool_mix(z[..., :POOL_WIDTH], pool_in[j], pos0, pool_w[j], pool_scale[j])
                y_rwkv, shift_new, wkv_new = rwkv7_mix(
                    z[..., POOL_WIDTH:], shift_in[j], wkv_in[j], rwkv_mu[j], rwkv_w0[j], rwkv_w2[j],
                    rwkv_a0[j], rwkv_a2[j], rwkv_g2[j], rwkv_k_k[j], rwkv_k_a[j], rwkv_r_k[j],
                    rwkv_gn_g[j], rwkv_gn_b[j])
                mix = jnp.concatenate([y_pool, y_rwkv], axis=-1) @ w_out_ab[j]
                pool_out.append(pool_new)
                shift_out.append(shift_new)
                wkv_out.append(wkv_new)
            else:
                mix, v_rows = sgu_mix(h, w_in_c[j], sgu_ln_g[j], sgu_ln_b[j], sgu_w_s[j], sgu_b_s[j], w_out_c[j])
                sgu_v_out.append(v_rows)
            x = x + mix
            x = x + cross_attn(rmsnorm(x, norm_xa_g[l]), mem_k[l], mem_v[l], w_xq[l], w_xo[l])
            x = x + sq_relu_mlp(rmsnorm(x, norm_ffn_g[l]), w_ff_up[l], w_ff_down[l])
        return (rmsnorm(x, norm_final_g), jnp.stack(pool_out), jnp.stack(shift_out),
                jnp.stack(wkv_out), sgu_v_out)

    kv = [memory_kv(mem_prompt, norm_mem_g[l], w_xk[l], w_xv[l]) for l in range(DEPTH)]
    mem_k_prompt = jnp.stack([kv_l[0] for kv_l in kv])
    mem_v_prompt = jnp.stack([kv_l[1] for kv_l in kv])
    bp = x_prompt.shape[0]
    dt = x_prompt.dtype
    pool0 = jnp.zeros((N_AB_LAYERS, bp, POOL_BUF, POOL_WIDTH), dt)
    shift0 = jnp.zeros((N_AB_LAYERS, bp, RWKV_IN), dt)
    wkv0 = jnp.zeros((N_AB_LAYERS, bp, RWKV_HEADS, RWKV_HEAD, RWKV_HEAD), dt)
    y_prompt, pool_prompt, shift_prompt, wkv_prompt, _ = trunk(
        x_prompt, 0, mem_k_prompt, mem_v_prompt, pool0, shift0, wkv0)

    y_sample, pool_sample, shift_sample, wkv_sample, sgu_v = trunk(
        x_sample, PAST_LEN, cache_mem_k, cache_mem_v, state_pool, state_shift, state_wkv)
    sgu_v_sample = jnp.stack(sgu_v)

    return (y_prompt, y_sample, mem_k_prompt, mem_v_prompt, pool_prompt, pool_sample,
            shift_prompt, shift_sample, wkv_prompt, wkv_sample, sgu_v_sample)
```

```cpp
#include <hip/hip_runtime.h>
#include <hip/hip_cooperative_groups.h>
#include <cstdio>
#include <cstdint>
namespace cg = cooperative_groups;
namespace pg8 {
#define PG8_LAS __attribute__((address_space(3)))
typedef unsigned short bf16_t;
typedef short bf16x8 __attribute__((ext_vector_type(8)));
typedef float f32x4 __attribute__((ext_vector_type(4)));
typedef unsigned u32x4 __attribute__((ext_vector_type(4)));
constexpr int BM = 256, BK = 64, HALF = 128, HTB = HALF * BK * 2  , STAGE_BYTES = 8 * HTB, NXCD = 8, WGM = 8;

__host__ __device__ __forceinline__ int lds_byte(int r, int c) { const int st = (r >> 4) * 2 + (c >> 5), rr = r & 15, cc = c & 31, ob = rr * 64 + cc * 2; return st * 1024 + (ob ^ (((ob >> 9) & 1) << 5)); }
__host__ __device__ __forceinline__ void stage_rc(int b, int& R, int& C) { const int st = b / 1024, sb = b % 1024, swz = sb ^ (((sb >> 9) & 1) << 5); R = (st >> 1) * 16 + swz / 64; C = (st & 1) * 32 + (swz % 64) / 2; }
__host__ __device__ __forceinline__ int perm32(int rho) { const int n = rho >> 4, i = rho & 15; return 8 * (i >> 2) + 4 * n + (i & 3); }

struct Unit { int pm, pn; };
struct Gemm { const bf16_t* A; const bf16_t* Bt; int M, N, K; };

struct StaticOrder {
    int nM, nN, nwg, G, c;
    __host__ __device__ void init(int M, int N, int G_, int c_) { nM = M / BM; nN = N / BM; nwg = nM * nN; G = G_; c = c_; }
    __host__ __device__ bool next(int i, Unit& u) const {
        const long L = (long)i * G + c; if (L >= nwg) return false;
        int wgid = (int)L; { const int q = nwg / NXCD, r = nwg % NXCD, xcd = wgid % NXCD, off = wgid / NXCD; wgid = (xcd < r ? xcd * (q + 1) : r * (q + 1) + (xcd - r) * q) + off; }
        const int nig = WGM * nN, gid = wgid / nig, fm = gid * WGM, gsz = (nM - fm) < WGM ? (nM - fm) : WGM;
        u.pm = fm + ((wgid % nig) % gsz); u.pn = (wgid % nig) / gsz; return true;
    }
    __device__ __forceinline__ void a_ready(const Unit&) const {}
    __device__ __forceinline__ void done(const Unit&) const {}
};

__device__ __forceinline__ unsigned cvt_pk_bf16(float lo, float hi) { unsigned r; asm volatile("v_cvt_pk_bf16_f32 %0, %1, %2" : "=v"(r) : "v"(lo), "v"(hi)); return r; }
typedef float f32x2 __attribute__((ext_vector_type(2)));
__device__ __forceinline__ f32x2 gelu_pk(f32x2 v) {
    const f32x2 av = __builtin_elementwise_abs(v), d = av * 0.2316418882f + 1.0f;
    f32x2 t; t.x = __builtin_amdgcn_rcpf(d.x); t.y = __builtin_amdgcn_rcpf(d.y);
    f32x2 q = t * 0.5307027145f + (-0.7265760135f); q = q * t + 0.7107068705f; q = q * t + (-0.142248368f); q = q * t + 0.127414796f; q = q * t;
    const f32x2 s = (v * v) * (-0.72134752044f);
    f32x2 e; e.x = __builtin_amdgcn_exp2f(s.x); e.y = __builtin_amdgcn_exp2f(s.y);
    const f32x2 m = v * (q * e), r = v - m;
    f32x2 o; o.x = v.x < 0.f ? m.x : r.x; o.y = v.y < 0.f ? m.y : r.y; return o;
}
template <class Epi, class Sched, bool ALIGN_EPI = false, bool SP2 = false>
__device__ __forceinline__ void gemm_phase(PG8_LAS unsigned char* lds, const Gemm g, const Sched& S, const Epi& E) {
    const int tid = threadIdx.x, wid = __builtin_amdgcn_readfirstlane(tid >> 6), lane = tid & 63, wr = wid >> 2, wc = wid & 3, fr = lane & 15, fq = lane >> 4;
    const int K = g.K, nt = K / BK;
    unsigned voffA[2], voffB[2];
#pragma unroll
    for (int i = 0; i < 2; ++i) { int R, C; stage_rc(tid * 16 + i * 8192, R, C); const int Rb = Epi::PERM ? ((R & ~31) + perm32(R & 31)) : R;
        voffA[i] = (unsigned)(R * K + C) * 2u; voffB[i] = (unsigned)(Rb * K + C) * 2u; }
    const size_t kstep = (size_t)(BK * 2);
    const size_t hstep = (size_t)HALF * K * 2;
    const size_t tstep = 2 * hstep;
    const unsigned ldsw = (unsigned)wid * 1024u;
    const int aoff = lds_byte(wr * 64 + fr, fq * 8), boff = lds_byte(wc * 32 + fr, fq * 8);
#define PG8_SA(b, h) (((b) * 2 + (h)) * HTB)
#define PG8_SB(b, h) ((4 + (b) * 2 + (h)) * HTB)
#define PG8_STAGE(bufoff, gbase, voff) do { _Pragma("unroll") for (int _i = 0; _i < 2; ++_i) \
        __builtin_amdgcn_global_load_lds((const unsigned*)((const char*)(gbase) + (voff)[_i]), (PG8_LAS unsigned*)(lds + (bufoff) + ldsw + _i * 8192), 16, 0, 0); } while (0)
#define PG8_LDA(dst, b, h) do { _Pragma("unroll") for (int m = 0; m < 4; ++m) _Pragma("unroll") for (int k = 0; k < 2; ++k) dst[m][k] = *(const PG8_LAS bf16x8*)(lds + PG8_SA(b, h) + aoff + m * 2048 + k * 1024); } while (0)
#define PG8_LDB(dst, b, h) do { _Pragma("unroll") for (int n = 0; n < 2; ++n) _Pragma("unroll") for (int k = 0; k < 2; ++k) dst[n][k] = *(const PG8_LAS bf16x8*)(lds + PG8_SB(b, h) + boff + n * 2048 + k * 1024); } while (0)
#define PG8_MMA(ai, bj, At, Bt) do { __builtin_amdgcn_s_setprio(1); _Pragma("unroll") for (int m = 0; m < 4; ++m) _Pragma("unroll") for (int n = 0; n < 2; ++n) _Pragma("unroll") for (int k = 0; k < 2; ++k) \
        acc[ai][bj][m][n] = __builtin_amdgcn_mfma_f32_16x16x32_bf16(Bt[n][k], At[m][k], acc[ai][bj][m][n], 0, 0, 0); __builtin_amdgcn_s_setprio(0); } while (0)
#define PG8_WAIT_V(n) asm volatile("s_waitcnt vmcnt(" #n ")" ::: "memory")
#define PG8_WAIT_L(n) asm volatile("s_waitcnt lgkmcnt(" #n ")" ::: "memory")
#define PG8_BAR __builtin_amdgcn_s_barrier()
#define PG8_SCHED __builtin_amdgcn_sched_barrier(0)
    Unit cur, nxt; int ui = 0;
    if (!S.next(0, cur)) return;
    f32x4 acc[2][2][4][2];
#pragma unroll
    for (int a = 0; a < 2; ++a)
#pragma unroll
        for (int b = 0; b < 2; ++b)
#pragma unroll
            for (int m = 0; m < 4; ++m)
#pragma unroll
                for (int n = 0; n < 2; ++n) acc[a][b][m][n] = (f32x4){0.f, 0.f, 0.f, 0.f};
    bf16x8 At[4][2], B0[2][2], B1[2][2];
    const char* cA = (const char*)g.A + (size_t)cur.pm * tstep; const char* cB = (const char*)g.Bt + (size_t)cur.pn * tstep;
    S.a_ready(cur);
    if constexpr (SP2) {
        PG8_STAGE(PG8_SB(0, 0), cB, voffB); PG8_STAGE(PG8_SB(0, 1), cB + hstep, voffB); PG8_STAGE(PG8_SA(0, 0), cA, voffA); PG8_STAGE(PG8_SA(0, 1), cA + hstep, voffA);
        if (wr == 1) PG8_BAR;
        PG8_WAIT_V(2); PG8_BAR;
        PG8_STAGE(PG8_SB(1, 0), cB + kstep, voffB); PG8_STAGE(PG8_SA(1, 0), cA + kstep, voffA); PG8_STAGE(PG8_SB(1, 1), cB + hstep + kstep, voffB);
        PG8_WAIT_V(6); PG8_BAR;
    } else {
        PG8_STAGE(PG8_SB(0, 0), cB, voffB); PG8_STAGE(PG8_SA(0, 0), cA, voffA); PG8_STAGE(PG8_SB(0, 1), cB + hstep, voffB); PG8_STAGE(PG8_SA(0, 1), cA + hstep, voffA);
        if (wr == 1) PG8_BAR;
        PG8_WAIT_V(4); PG8_BAR;
        PG8_STAGE(PG8_SB(1, 0), cB + kstep, voffB); PG8_STAGE(PG8_SA(1, 0), cA + kstep, voffA); PG8_STAGE(PG8_SB(1, 1), cB + hstep + kstep, voffB);
        PG8_WAIT_V(6); PG8_BAR;
    }
    for (;;) {
        const bool has_next = S.next(ui + 1, nxt);
        const char* nA = has_next ? (const char*)g.A + (size_t)nxt.pm * tstep : cA; const char* nB = has_next ? (const char*)g.Bt + (size_t)nxt.pn * tstep : cB;
        for (int t = 0; t < nt; t += 2) {
            const bool last = (t == nt - 2);
            const char* a1 = cA + (size_t)(t + 1) * kstep;
            const char* a2 = last ? nA : cA + (size_t)(t + 2) * kstep; const char* b2 = last ? nB : cB + (size_t)(t + 2) * kstep;
            const char* a3 = a2 + kstep; const char* b3 = b2 + kstep;
            if (last && has_next) S.a_ready(nxt);
            if constexpr (SP2) {
            PG8_LDB(B0, 0, 0); PG8_LDB(B1, 0, 1); PG8_SCHED; PG8_LDA(At, 0, 0); PG8_STAGE(PG8_SA(1, 1), a1 + hstep, voffA);
            PG8_WAIT_V(8); PG8_WAIT_L(0); PG8_BAR; PG8_MMA(0, 0, At, B0); PG8_MMA(0, 1, At, B1); PG8_BAR; PG8_SCHED;
            PG8_LDA(At, 0, 1); PG8_STAGE(PG8_SB(0, 0), b2, voffB); PG8_STAGE(PG8_SB(0, 1), b2 + hstep, voffB); PG8_STAGE(PG8_SA(0, 0), a2, voffA);
            PG8_WAIT_V(8); PG8_WAIT_L(0); PG8_BAR; PG8_MMA(1, 0, At, B0); PG8_MMA(1, 1, At, B1); PG8_BAR; PG8_SCHED;
            PG8_LDB(B0, 1, 0); PG8_LDB(B1, 1, 1); PG8_SCHED; PG8_LDA(At, 1, 0); PG8_STAGE(PG8_SA(0, 1), a2 + hstep, voffA);
            PG8_WAIT_V(8); PG8_WAIT_L(0); PG8_BAR; PG8_MMA(0, 0, At, B0); PG8_MMA(0, 1, At, B1); PG8_BAR; PG8_SCHED;
            PG8_LDA(At, 1, 1); PG8_STAGE(PG8_SB(1, 0), b3, voffB); PG8_STAGE(PG8_SB(1, 1), b3 + hstep, voffB); PG8_STAGE(PG8_SA(1, 0), a3, voffA);
            PG8_WAIT_V(8); PG8_WAIT_L(0); PG8_BAR; PG8_MMA(1, 0, At, B0); PG8_MMA(1, 1, At, B1); PG8_BAR; PG8_SCHED;
            } else {
            PG8_LDB(B0, 0, 0); PG8_SCHED; PG8_LDA(At, 0, 0); PG8_STAGE(PG8_SA(1, 1), a1 + hstep, voffA);
            PG8_WAIT_L(8); PG8_BAR; PG8_WAIT_L(0); PG8_MMA(0, 0, At, B0); PG8_BAR; PG8_SCHED;
            PG8_LDB(B1, 0, 1); PG8_STAGE(PG8_SB(0, 0), b2, voffB);
            PG8_BAR; PG8_WAIT_L(0); PG8_MMA(0, 1, At, B1); PG8_BAR;
            PG8_LDA(At, 0, 1); PG8_STAGE(PG8_SA(0, 0), a2, voffA);
            PG8_BAR; PG8_WAIT_L(0); PG8_MMA(1, 0, At, B0); PG8_BAR; PG8_SCHED;
            PG8_STAGE(PG8_SB(0, 1), b2 + hstep, voffB);
            PG8_WAIT_V(6); PG8_BAR; PG8_MMA(1, 1, At, B1); PG8_BAR;
            PG8_LDB(B0, 1, 0); PG8_SCHED; PG8_LDA(At, 1, 0); PG8_STAGE(PG8_SA(0, 1), a2 + hstep, voffA);
            PG8_WAIT_L(8); PG8_BAR; PG8_WAIT_L(0); PG8_MMA(0, 0, At, B0); PG8_BAR; PG8_SCHED;
            PG8_LDB(B1, 1, 1); PG8_STAGE(PG8_SB(1, 0), b3, voffB);
            PG8_BAR; PG8_WAIT_L(0); PG8_MMA(0, 1, At, B1); PG8_BAR;
            PG8_LDA(At, 1, 1); PG8_STAGE(PG8_SA(1, 0), a3, voffA);
            PG8_BAR; PG8_WAIT_L(0); PG8_MMA(1, 0, At, B0); PG8_BAR; PG8_SCHED;
            PG8_STAGE(PG8_SB(1, 1), b3 + hstep, voffB);
            PG8_WAIT_V(6); PG8_BAR; PG8_MMA(1, 1, At, B1); PG8_BAR;
            }
        }
        if constexpr (ALIGN_EPI) { if (wr == 0) PG8_BAR; }
        if constexpr (!Epi::AFTER_DRAIN) { E(acc, cur, wr, wc, fr, fq); S.done(cur); }
        if (!has_next) break;
#pragma unroll
        for (int a = 0; a < 2; ++a)
#pragma unroll
            for (int b = 0; b < 2; ++b)
#pragma unroll
                for (int m = 0; m < 4; ++m)
#pragma unroll
                    for (int n = 0; n < 2; ++n) acc[a][b][m][n] = (f32x4){0.f, 0.f, 0.f, 0.f};
        cur = nxt; cA = nA; cB = nB; ++ui;
        if constexpr (ALIGN_EPI) { if (wr == 1) PG8_BAR; }
    }
    PG8_WAIT_V(0);
    if constexpr (!ALIGN_EPI) { if (wr == 0) PG8_BAR; }
    PG8_BAR;
    if constexpr (Epi::AFTER_DRAIN) { E.fused(acc, cur, wr, wc, fr, fq, lds, wid, lane); S.done(cur); }
#undef PG8_SA
#undef PG8_SB
#undef PG8_STAGE
#undef PG8_LDA
#undef PG8_LDB
#undef PG8_MMA
#undef PG8_WAIT_V
#undef PG8_WAIT_L
#undef PG8_BAR
#undef PG8_SCHED
}
}

using pg8::bf16_t; using pg8::bf16x8; using pg8::f32x4; using pg8::u32x4; using pg8::f32x2; using pg8::Unit; using pg8::cvt_pk_bf16;
#define LAS __attribute__((address_space(3)))
typedef short bf16x4 __attribute__((ext_vector_type(4)));
typedef unsigned u32x2 __attribute__((ext_vector_type(2)));

constexpr int DM = 1024, SEQ = 2048, NBP = 8, MP = 16384, MS = 128, MR = 16512, MT = 16640, MMEM = 2048;
constexpr int ABIN = 2304, RIN = 1792, PW = 512, DFF = 4096, SGW = 2048;
constexpr float RMS_EPS = 1e-5f, LN_EPS = 1e-5f, GN_EPS = 64e-5f;
constexpr float QSCALE = 0.0625f * 1.4426950408889634f;

constexpr size_t O_YP = 0, O_YS = 16777216, O_MK = 16908288, O_MV = 21102592, O_PP = 25296896, O_PS = 25358336, O_SHP = 26341376, O_SHS = 26355712,
                 O_WKP = 26585088, O_WKS = 26847232, O_SGV = 31041536;

constexpr size_t al256(size_t x) { return (x + 255) & ~(size_t)255; }
constexpr size_t OFF_WA = 0;
constexpr size_t OFF_WOAB = OFF_WA + (size_t)6400 * 1024 * 2;
constexpr size_t OFF_WQ = OFF_WOAB + (size_t)1024 * 1024 * 2;
constexpr size_t OFF_WO = OFF_WQ + (size_t)2 * 1024 * 1024 * 2;
constexpr size_t OFF_WUP = OFF_WO + (size_t)2 * 1024 * 1024 * 2;
constexpr size_t OFF_WDN = OFF_WUP + (size_t)2 * 4096 * 1024 * 2;
constexpr size_t OFF_WINC = OFF_WDN + (size_t)2 * 4096 * 1024 * 2;
constexpr size_t OFF_WOUTC = OFF_WINC + (size_t)4096 * 1024 * 2;
constexpr size_t OFF_POOLWT = OFF_WOUTC + (size_t)2048 * 1024 * 2;
constexpr size_t OFF_W2T = OFF_POOLWT + (size_t)4 * 128 * 128 * 2;
constexpr size_t OFF_A2T = OFF_W2T + (size_t)512 * 64 * 2;
constexpr size_t OFF_G2T = OFF_A2T + (size_t)512 * 64 * 2;
constexpr size_t OFF_XB = OFF_G2T + (size_t)512 * 128 * 2;
constexpr size_t OFF_X = OFF_XB + (size_t)(MT + MMEM) * 1024 * 2;
constexpr size_t OFF_SSQP = OFF_X + (size_t)MT * 1024 * 4;
constexpr size_t OFF_MSSQ = OFF_SSQP + (size_t)MT * 16 * 4;
constexpr size_t OFF_Z = OFF_MSSQ + (size_t)MMEM * 4;
constexpr size_t OFF_SC = OFF_Z + (size_t)MT * ABIN * 4;
constexpr size_t OFF_GATE = OFF_SC + (size_t)MR * 8 * 384 * 4;
constexpr size_t OFF_YR = OFF_GATE + (size_t)MT * 512 * 4;
constexpr size_t OFF_CAT = OFF_YR + (size_t)MT * 512 * 4;
constexpr size_t OFF_Q = OFF_CAT + (size_t)MT * 1024 * 2;
constexpr size_t OFF_OAT = OFF_Q + (size_t)MT * 1024 * 2;
constexpr size_t OFF_KB = OFF_OAT + (size_t)MT * 1024 * 2;
constexpr size_t OFF_VT = OFF_KB + (size_t)2 * 2048 * 1024 * 2;
constexpr size_t OFF_LNP = OFF_VT + (size_t)2 * 2048 * 1024 * 2;
constexpr size_t OFF_BAR = OFF_LNP + (size_t)MT * 64 * 4;
constexpr size_t OFF_END = OFF_BAR + 16384;
constexpr size_t OFF_U = OFF_Z;
constexpr size_t OFF_U2 = OFF_Z;
constexpr size_t OFF_VPRE = OFF_SC;
constexpr size_t OFF_G2 = OFF_GATE;
static_assert((size_t)MT * 4096 * 2 <= (size_t)MT * ABIN * 4 && (size_t)MT * 2048 * 4 <= (size_t)MR * 8 * 384 * 4 && (size_t)MT * 2048 * 2 <= (size_t)2 * MT * 512 * 4, "overlays");
static_assert(OFF_XB % 256 == 0 && OFF_Z % 256 == 0 && OFF_SC % 256 == 0 && OFF_CAT % 256 == 0 && OFF_VT % 256 == 0 && OFF_LNP % 256 == 0, "align");

constexpr int LDS_BYTES = 139264;

struct Params { const float* in[40]; float* out; unsigned char* ws; int lo, hi; };

struct Ctx {
    const float* const* in; float* out; unsigned char* ws;
    int tid, lane, wave, G, bid;
    LAS unsigned char* lds;
};
#define WSP(T, off) ((T*)(c.ws + (off)))
#define LDS_BARRIER() do { asm volatile("s_waitcnt lgkmcnt(0)" ::: "memory"); __builtin_amdgcn_s_barrier(); asm volatile("" ::: "memory"); } while (0)

__device__ __forceinline__ float wave_sum(float v) {
#pragma unroll
    for (int o = 32; o >= 1; o >>= 1) v += __shfl_xor(v, o);
    return v;
}
__device__ __forceinline__ float wave_max(float v) {
#pragma unroll
    for (int o = 32; o >= 1; o >>= 1) v = fmaxf(v, __shfl_xor(v, o));
    return v;
}
__device__ __forceinline__ float bf2f(unsigned short b) { return __uint_as_float(((unsigned)b) << 16); }
__device__ __forceinline__ float sigmoidf_(float x) { return __builtin_amdgcn_rcpf(1.0f + __expf(-x)); }
__device__ __forceinline__ float tanhf_(float x) { return 1.0f - 2.0f * __builtin_amdgcn_rcpf(__expf(2.0f * x) + 1.0f); }
__device__ __forceinline__ const float* x0_row(const Ctx& c, int row) {
    return row < MP ? c.in[0] + (size_t)row * DM : c.in[1] + (size_t)((row - MP) & 127) * DM;
}
__device__ __forceinline__ float rstd_row(const float* SSQP, int row) {
    const f32x4* p = (const f32x4*)(SSQP + (size_t)row * 16);
    const f32x4 a = p[0], b = p[1], cc = p[2], d = p[3];
    const float s = ((a[0] + a[1]) + (a[2] + a[3])) + ((b[0] + b[1]) + (b[2] + b[3])) + ((cc[0] + cc[1]) + (cc[2] + cc[3])) + ((d[0] + d[1]) + (d[2] + d[3]));
    return rsqrtf(s * (1.0f / 1024.0f) + RMS_EPS);
}

struct TJob { const float* W; const float* g; bf16_t* dst; int K, N; };
constexpr int NJOBS = 23;
__device__ __forceinline__ TJob get_job(const Ctx& c, int j) {
    TJob t; t.g = nullptr;
    if (j == 0) { t.W = c.in[13]; t.g = c.in[8]; t.dst = WSP(bf16_t, OFF_WA); t.K = 1024; t.N = 2304; }
    else if (j <= 4) { const int i = j - 1, l = i >> 1, v = i & 1; t.W = c.in[v ? 36 : 35] + (size_t)l * 1048576; t.g = c.in[10] + l * 1024;
        t.dst = WSP(bf16_t, OFF_WA) + (size_t)(2304 + i * 1024) * 1024; t.K = 1024; t.N = 1024; }
    else if (j == 5) { t.W = c.in[14]; t.dst = WSP(bf16_t, OFF_WOAB); t.K = 1024; t.N = 1024; }
    else if (j <= 7) { const int l = j - 6; t.W = c.in[34] + (size_t)l * 1048576; t.g = c.in[9] + l * 1024; t.dst = WSP(bf16_t, OFF_WQ) + (size_t)l * 1048576; t.K = 1024; t.N = 1024; }
    else if (j <= 9) { const int l = j - 8; t.W = c.in[37] + (size_t)l * 1048576; t.dst = WSP(bf16_t, OFF_WO) + (size_t)l * 1048576; t.K = 1024; t.N = 1024; }
    else if (j <= 11) { const int l = j - 10; t.W = c.in[38] + (size_t)l * 4194304; t.g = c.in[11] + l * 1024; t.dst = WSP(bf16_t, OFF_WUP) + (size_t)l * 4194304; t.K = 1024; t.N = 4096; }
    else if (j <= 13) { const int l = j - 12; t.W = c.in[39] + (size_t)l * 4194304; t.dst = WSP(bf16_t, OFF_WDN) + (size_t)l * 4194304; t.K = 4096; t.N = 1024; }
    else if (j == 14) { t.W = c.in[28]; t.g = c.in[8] + 1024; t.dst = WSP(bf16_t, OFF_WINC); t.K = 1024; t.N = 4096; }
    else if (j == 15) { t.W = c.in[33]; t.dst = WSP(bf16_t, OFF_WOUTC); t.K = 2048; t.N = 1024; }
    else if (j <= 19) { const int g = j - 16; t.W = c.in[15] + g * 16384; t.dst = WSP(bf16_t, OFF_POOLWT) + g * 16384; t.K = 128; t.N = 128; }
    else if (j == 20) { t.W = c.in[19]; t.dst = WSP(bf16_t, OFF_W2T); t.K = 64; t.N = 512; }
    else if (j == 21) { t.W = c.in[21]; t.dst = WSP(bf16_t, OFF_A2T); t.K = 64; t.N = 512; }
    else { t.W = c.in[22]; t.dst = WSP(bf16_t, OFF_G2T); t.K = 128; t.N = 512; }
    return t;
}

__device__ __forceinline__ void phase_prologue(const Ctx& c) {
    LAS float* tile = (LAS float*)c.lds;
    {
        int off = 0;
#pragma unroll 1
        for (int j = 0; j < NJOBS; ++j) {
            const TJob t = get_job(c, j);
            const int ntn = t.N >> 6, nt = (t.K >> 6) * ntn;
            int first = c.bid - off; if (first < 0) first += c.G;
            off = (off + nt) % c.G;
            f32x4 pv[2]; float pg[2];
#define PRO_LOAD(ti_) do { const int k0_ = ((ti_) / ntn) * 64, n0_ = ((ti_) % ntn) * 64; _Pragma("unroll") for (int i = 0; i < 2; ++i) { const int kk = (c.tid >> 4) + i * 32, nn = (c.tid & 15) * 4; \
                pv[i] = *(const f32x4*)(t.W + (size_t)(k0_ + kk) * t.N + n0_ + nn); pg[i] = t.g ? t.g[k0_ + kk] : 1.0f; } } while (0)
            if (first < nt) PRO_LOAD(first);
            for (int ti = first; ti < nt; ti += c.G) {
                const int k0 = (ti / ntn) * 64, n0 = (ti % ntn) * 64;
#pragma unroll
                for (int i = 0; i < 2; ++i) {
                    const int kk = (c.tid >> 4) + i * 32, nn = (c.tid & 15) * 4;
                    tile[kk * 65 + nn + 0] = pv[i][0] * pg[i]; tile[kk * 65 + nn + 1] = pv[i][1] * pg[i]; tile[kk * 65 + nn + 2] = pv[i][2] * pg[i]; tile[kk * 65 + nn + 3] = pv[i][3] * pg[i];
                }
                LDS_BARRIER();
                if (ti + c.G < nt) PRO_LOAD(ti + c.G);
                {
                    const int n = c.tid >> 3, kq = (c.tid & 7) * 8;
                    u32x4 w;
                    w.x = cvt_pk_bf16(tile[(kq + 0) * 65 + n], tile[(kq + 1) * 65 + n]); w.y = cvt_pk_bf16(tile[(kq + 2) * 65 + n], tile[(kq + 3) * 65 + n]);
                    w.z = cvt_pk_bf16(tile[(kq + 4) * 65 + n], tile[(kq + 5) * 65 + n]); w.w = cvt_pk_bf16(tile[(kq + 6) * 65 + n], tile[(kq + 7) * 65 + n]);
                    *(u32x4*)(t.dst + (size_t)(n0 + n) * t.K + k0 + kq) = w;
                }
                LDS_BARRIER();
            }
#undef PRO_LOAD
        }
    }
    for (int i = c.bid * 512 + c.tid; i < MS * 14 * (PW / 4); i += c.G * 512) {
        const int b = i / (14 * (PW / 4)), r = i % (14 * (PW / 4));
        *(f32x4*)(c.out + O_PS + (size_t)b * 15 * PW + (size_t)r * 4) = *(const f32x4*)(c.in[5] + (size_t)b * 15 * PW + PW + (size_t)r * 4);
    }
    bf16_t* XB = WSP(bf16_t, OFF_XB); float* SSQP = WSP(float, OFF_SSQP); float* MSSQ = WSP(float, OFF_MSSQ);
    const int gw = c.bid * 8 + c.wave, nw = c.G * 8;
    for (int row = gw; row < MT + MMEM; row += nw) {
        const float* src = row < MT ? x0_row(c, row) : c.in[2] + (size_t)(row - MT) * DM;
        float ss = 0.f;
#pragma unroll
        for (int i = 0; i < 4; ++i) {
            const int col = i * 256 + c.lane * 4;
            const f32x4 v = *(const f32x4*)(src + col);
            ss += v[0] * v[0] + v[1] * v[1] + v[2] * v[2] + v[3] * v[3];
            u32x2 w; w.x = cvt_pk_bf16(v[0], v[1]); w.y = cvt_pk_bf16(v[2], v[3]);
            *(u32x2*)(XB + (size_t)row * DM + col) = w;
        }
        ss = wave_sum(ss);
        if (row < MT) { if (c.lane < 16) SSQP[(size_t)row * 16 + c.lane] = c.lane == 0 ? ss : 0.f; }
        else if (c.lane == 0) MSSQ[row - MT] = ss;
    }
}

struct Order2 {
    int nM0, nN0, n0, nM1, nN1, n1, pmo, pno, G, c, dup = 1;
    __device__ __forceinline__ void init(int nM0_, int nN0_, int G_, int c_) { nM0 = nM0_; nN0 = nN0_; n0 = nM0 * nN0; nM1 = 0; nN1 = 1; n1 = 0; pmo = 0; pno = 0; G = G_; c = c_; }
    __device__ __forceinline__ void add(int nM1_, int nN1_, int pmo_, int pno_) { nM1 = nM1_; nN1 = nN1_; n1 = nM1 * nN1; pmo = pmo_; pno = pno_; }
    __device__ __forceinline__ static void map(int w, int nM, int nN, Unit& u) {
        const int nig = pg8::WGM * nN, gid = w / nig, fm = gid * pg8::WGM, gsz = (nM - fm) < pg8::WGM ? (nM - fm) : pg8::WGM;
        u.pm = fm + ((w % nig) % gsz); u.pn = (w % nig) / gsz;
    }
    __device__ __forceinline__ bool next(int i, Unit& u) const {
        const long L = (long)(i / dup) * G + c; const int nwg = n0 + n1; if (L >= nwg) return false;
        int w = (int)L; { const int q = nwg / 8, r = nwg % 8, xcd = w % 8, off = w / 8; w = (xcd < r ? xcd * (q + 1) : r * (q + 1) + (xcd - r) * q) + off; }
        if (w < n0) map(w, nM0, nN0, u); else { map(w - n0, nM1, nN1, u); u.pm += pmo; u.pn += pno; }
        return true;
    }
    __device__ __forceinline__ void a_ready(const Unit&) const {}
    __device__ __forceinline__ void done(const Unit&) const {}
};

#ifndef WT_STORES
#define WT_STORES 0
#endif
__device__ __forceinline__ void st16(void* p, u32x4 v) {
#if WT_STORES
    asm volatile("global_store_dwordx4 %0, %1, off sc0 sc1" :: "v"(p), "v"(v) : "memory");
#else
    *(u32x4*)p = v;
#endif
}
__device__ __forceinline__ void st16f(float* p, f32x4 v) { st16((void*)p, __builtin_bit_cast(u32x4, v)); }
#define EPI_ARGS const f32x4 (&acc)[2][2][4][2], const Unit& u, int wr, int wc, int fr, int fq
#define EPI_RS8(rs, SSQP_, row0) float rs[2][4]; { f32x4 t_[2][4]; \
    _Pragma("unroll") for (int ai = 0; ai < 2; ++ai) _Pragma("unroll") for (int m = 0; m < 4; ++m) t_[ai][m] = *((const f32x4*)((SSQP_) + (size_t)((row0) + ai * 128 + m * 16) * 16) + fq); \
    _Pragma("unroll") for (int ai = 0; ai < 2; ++ai) _Pragma("unroll") for (int m = 0; m < 4; ++m) { float q_ = (t_[ai][m][0] + t_[ai][m][1]) + (t_[ai][m][2] + t_[ai][m][3]); \
        q_ += __shfl_xor(q_, 16); q_ += __shfl_xor(q_, 32); rs[ai][m] = rsqrtf(q_ * (1.0f / 1024.0f) + RMS_EPS); } }
struct EpiInMem {
    static constexpr bool PERM = true, AFTER_DRAIN = false;
    const float* SSQP; const float* MSSQ; bf16_t* Z; float* out; bf16_t* KB; bf16_t* VT;
    __device__ __forceinline__ float sk_scale(int row) const { return rstd_row(SSQP, row); }
    __device__ __forceinline__ f32x4 sk_pre(int row, int col) const { return (f32x4){0.f, 0.f, 0.f, 0.f}; }
    __device__ __forceinline__ void sk_elem(int row, int col, f32x4 v, f32x4 pre, float rs, float& s1, float& s2) const {
        v = v * rs; { u32x2 w; w.x = cvt_pk_bf16(v[0], v[1]); w.y = cvt_pk_bf16(v[2], v[3]); *(u32x2*)(Z + (size_t)row * ABIN + col) = w; }
        if (col >= PW) *(f32x4*)(out + O_SHS + (size_t)(row - MP) * RIN + (col - PW)) = v;
        else *(f32x4*)(out + O_PS + ((size_t)(row - MP) * 15 + 14) * PW + col) = v;
    }
    __device__ __forceinline__ void sk_fin(int row, int slot, float s1, float s2) const {}
    __device__ __forceinline__ void operator()(EPI_ARGS) const {
        if (u.pn < 9) {
            EPI_RS8(rs8, SSQP, u.pm * 256 + wr * 64 + fr);
#pragma unroll
            for (int ai = 0; ai < 2; ++ai)
#pragma unroll
                for (int m = 0; m < 4; ++m) {
                    const int row = u.pm * 256 + ai * 128 + wr * 64 + m * 16 + fr; const float rs = rs8[ai][m];
#pragma unroll
                    for (int bj = 0; bj < 2; ++bj) { const f32x4 v0 = acc[ai][bj][m][0] * rs, v1 = acc[ai][bj][m][1] * rs;
                        u32x4 w; w.x = cvt_pk_bf16(v0[0], v0[1]); w.y = cvt_pk_bf16(v0[2], v0[3]); w.z = cvt_pk_bf16(v1[0], v1[1]); w.w = cvt_pk_bf16(v1[2], v1[3]);
                        st16(Z + (size_t)row * ABIN + u.pn * 256 + bj * 128 + wc * 32 + 8 * fq, w); }
                }
        } else {
            const int j = u.pn - 9, l = j >> 3, isv = (j >> 2) & 1, cb = (j & 3) * 256;
            float* ob = out + (isv ? O_MV : O_MK) + (size_t)l * 2048 * 1024;
#pragma unroll
            for (int ai = 0; ai < 2; ++ai)
#pragma unroll
                for (int m = 0; m < 4; ++m) {
                    const int rm = (u.pm - 65) * 256 + ai * 128 + wr * 64 + m * 16 + fr; const float rs = rsqrtf(MSSQ[rm] * (1.0f / 1024.0f) + RMS_EPS);
#pragma unroll
                    for (int bj = 0; bj < 2; ++bj) {
                        const int col = cb + bj * 128 + wc * 32 + 8 * fq; const f32x4 v0 = acc[ai][bj][m][0] * rs, v1 = acc[ai][bj][m][1] * rs;
                        float* op = ob + (size_t)rm * 1024 + col; *(f32x4*)op = v0; *(f32x4*)(op + 4) = v1;
                        if (!isv) { u32x4 w; w.x = cvt_pk_bf16(v0[0], v0[1]); w.y = cvt_pk_bf16(v0[2], v0[3]); w.z = cvt_pk_bf16(v1[0], v1[1]); w.w = cvt_pk_bf16(v1[2], v1[3]);
                            *(u32x4*)(KB + ((size_t)l * 2048 + rm) * 1024 + col) = w; }
                        else { bf16_t* vp = VT + ((((size_t)l * 8 + (rm >> 8)) * 4 + (col >> 8)) * 256 + (col & 255)) * 256 + (rm & 255);
                            const unsigned a = cvt_pk_bf16(v0[0], v0[1]), b = cvt_pk_bf16(v0[2], v0[3]), cc = cvt_pk_bf16(v1[0], v1[1]), d = cvt_pk_bf16(v1[2], v1[3]);
                            vp[0] = (bf16_t)a; vp[256] = (bf16_t)(a >> 16); vp[512] = (bf16_t)b; vp[768] = (bf16_t)(b >> 16);
                            vp[1024] = (bf16_t)cc; vp[1280] = (bf16_t)(cc >> 16); vp[1536] = (bf16_t)d; vp[1792] = (bf16_t)(d >> 16); }
                    }
                }
        }
    }
};
struct EpiRes {
    static constexpr bool PERM = true, AFTER_DRAIN = false;
    bool first; const float* xp; const float* xs; bf16_t* XB; float* SSQP;
    __device__ __forceinline__ static f32x4 cvt4(u32x2 r) { return (f32x4){__uint_as_float(r.x << 16), __uint_as_float(r.x & 0xffff0000u), __uint_as_float(r.y << 16), __uint_as_float(r.y & 0xffff0000u)}; }
    __device__ __forceinline__ float sk_scale(int row) const { return 1.0f; }
    __device__ __forceinline__ f32x4 sk_pre(int row, int col) const {
        if (first) return *(const f32x4*)(xs + (size_t)(row - MP) * DM + col);
        return cvt4(*(const u32x2*)(XB + (size_t)row * DM + col));
    }
    __device__ __forceinline__ void sk_elem(int row, int col, f32x4 v, f32x4 pre, float rs, float& s1, float& s2) const {
        v += pre;
        u32x2 w; w.x = cvt_pk_bf16(v[0], v[1]); w.y = cvt_pk_bf16(v[2], v[3]); *(u32x2*)(XB + (size_t)row * DM + col) = w;
        s1 += (v[0] * v[0] + v[1] * v[1]) + (v[2] * v[2] + v[3] * v[3]);
    }
    __device__ __forceinline__ void sk_fin(int row, int slot, float s1, float s2) const { SSQP[(size_t)row * 16 + slot] = s1; }
    __device__ __forceinline__ void operator()(EPI_ARGS) const {
#pragma unroll
        for (int ai = 0; ai < 2; ++ai) {
            f32x4 xv[4][2][2];
            if (first) {
#pragma unroll
                for (int m = 0; m < 4; ++m) {
                    const int row = u.pm * 256 + ai * 128 + wr * 64 + m * 16 + fr;
                    const float* xo = xp + (size_t)row * DM;
#pragma unroll
                    for (int bj = 0; bj < 2; ++bj) { const int col = u.pn * 256 + bj * 128 + wc * 32 + 8 * fq; xv[m][bj][0] = *(const f32x4*)(xo + col); xv[m][bj][1] = *(const f32x4*)(xo + col + 4); }
                }
            } else {
                u32x4 xr[4][2];
#pragma unroll
                for (int m = 0; m < 4; ++m) {
                    const int row = u.pm * 256 + ai * 128 + wr * 64 + m * 16 + fr;
#pragma unroll
                    for (int bj = 0; bj < 2; ++bj) xr[m][bj] = *(const u32x4*)(XB + (size_t)row * DM + u.pn * 256 + bj * 128 + wc * 32 + 8 * fq);
                }
#pragma unroll
                for (int m = 0; m < 4; ++m)
#pragma unroll
                    for (int bj = 0; bj < 2; ++bj) { xv[m][bj][0] = cvt4((u32x2){xr[m][bj].x, xr[m][bj].y}); xv[m][bj][1] = cvt4((u32x2){xr[m][bj].z, xr[m][bj].w}); }
            }
            __builtin_amdgcn_sched_barrier(0);
#pragma unroll
            for (int m = 0; m < 4; ++m) {
                const int row = u.pm * 256 + ai * 128 + wr * 64 + m * 16 + fr;
                float ss = 0.f;
#pragma unroll
                for (int bj = 0; bj < 2; ++bj) {
                    const int col = u.pn * 256 + bj * 128 + wc * 32 + 8 * fq;
                    const f32x4 v0 = acc[ai][bj][m][0] + xv[m][bj][0], v1 = acc[ai][bj][m][1] + xv[m][bj][1];
                    u32x4 w; w.x = cvt_pk_bf16(v0[0], v0[1]); w.y = cvt_pk_bf16(v0[2], v0[3]); w.z = cvt_pk_bf16(v1[0], v1[1]); w.w = cvt_pk_bf16(v1[2], v1[3]);
                    st16(XB + (size_t)row * DM + col, w);
                    ss += (v0[0] * v0[0] + v0[1] * v0[1]) + (v0[2] * v0[2] + v0[3] * v0[3]) + (v1[0] * v1[0] + v1[1] * v1[1]) + (v1[2] * v1[2] + v1[3] * v1[3]);
                }
                ss += __shfl_xor(ss, 16); ss += __shfl_xor(ss, 32);
                if (fq == 0) SSQP[(size_t)row * 16 + u.pn * 4 + wc] = ss;
            }
        }
    }
};
template <int MODE> struct EpiNormBf16 {
    static constexpr bool PERM = true, AFTER_DRAIN = false;
    const float* SSQP; bf16_t* O; int ldc; float scale;
    __device__ __forceinline__ float sk_scale(int row) const { return rstd_row(SSQP, row) * scale; }
    __device__ __forceinline__ f32x4 sk_pre(int row, int col) const { return (f32x4){0.f, 0.f, 0.f, 0.f}; }
    __device__ __forceinline__ void sk_elem(int row, int col, f32x4 v, f32x4 pre, float rs, float& s1, float& s2) const {
        v = v * rs;
        if (MODE == 1) {
#pragma unroll
            for (int e = 0; e < 4; ++e) { const float a = fmaxf(v[e], 0.f); v[e] = a * a; }
        }
        u32x2 w; w.x = cvt_pk_bf16(v[0], v[1]); w.y = cvt_pk_bf16(v[2], v[3]); *(u32x2*)(O + (size_t)row * ldc + col) = w;
    }
    __device__ __forceinline__ void sk_fin(int row, int slot, float s1, float s2) const {}
    __device__ __forceinline__ void operator()(EPI_ARGS) const {
        EPI_RS8(rs8, SSQP, u.pm * 256 + wr * 64 + fr);
#pragma unroll
        for (int ai = 0; ai < 2; ++ai)
#pragma unroll
            for (int m = 0; m < 4; ++m) {
                const int row = u.pm * 256 + ai * 128 + wr * 64 + m * 16 + fr; const float rs = rs8[ai][m] * scale;
#pragma unroll
                for (int bj = 0; bj < 2; ++bj) {
                    const int col = u.pn * 256 + bj * 128 + wc * 32 + 8 * fq;
                    f32x4 v0 = acc[ai][bj][m][0] * rs, v1 = acc[ai][bj][m][1] * rs;
                    if (MODE == 1) {
#pragma unroll
                        for (int e = 0; e < 4; ++e) { const float a = fmaxf(v0[e], 0.f), b = fmaxf(v1[e], 0.f); v0[e] = a * a; v1[e] = b * b; }
                    }
                    u32x4 w; w.x = cvt_pk_bf16(v0[0], v0[1]); w.y = cvt_pk_bf16(v0[2], v0[3]); w.z = cvt_pk_bf16(v1[0], v1[1]); w.w = cvt_pk_bf16(v1[2], v1[3]);
                    st16(O + (size_t)row * ldc + col, w);
                }
            }
    }
};
struct EpiGelu {
    static constexpr bool PERM = true, AFTER_DRAIN = false;
    const float* SSQP; bf16_t* U2; bf16_t* VPRE; float* LNP;
    __device__ __forceinline__ float sk_scale(int row) const { return rstd_row(SSQP, row); }
    __device__ __forceinline__ f32x4 sk_pre(int row, int col) const { return (f32x4){0.f, 0.f, 0.f, 0.f}; }
    __device__ __forceinline__ void sk_elem(int row, int col, f32x4 v, f32x4 pre, float rs, float& s1, float& s2) const {
        v = v * rs;
        const f32x2 a = pg8::gelu_pk((f32x2){v[0], v[1]}), b = pg8::gelu_pk((f32x2){v[2], v[3]});
        v = (f32x4){a.x, a.y, b.x, b.y};
        if (col < SGW) { u32x2 w; w.x = cvt_pk_bf16(v[0], v[1]); w.y = cvt_pk_bf16(v[2], v[3]); *(u32x2*)(U2 + (size_t)row * SGW + col) = w; }
        else { u32x2 w; w.x = cvt_pk_bf16(v[0], v[1]); w.y = cvt_pk_bf16(v[2], v[3]); *(u32x2*)(VPRE + (size_t)row * SGW + (col - SGW)) = w; s1 += (v[0] + v[1]) + (v[2] + v[3]); s2 += (v[0] * v[0] + v[1] * v[1]) + (v[2] * v[2] + v[3] * v[3]); }
    }
    __device__ __forceinline__ void sk_fin(int row, int slot, float s1, float s2) const { if (slot >= 32) { float* lp = LNP + ((size_t)row * 32 + (slot - 32)) * 2; lp[0] = s1; lp[1] = s2; } }
    __device__ __forceinline__ void operator()(EPI_ARGS) const {
        EPI_RS8(rs8, SSQP, u.pm * 256 + wr * 64 + fr);
#pragma unroll
        for (int ai = 0; ai < 2; ++ai)
#pragma unroll
            for (int m = 0; m < 4; ++m) {
                const int row = u.pm * 256 + ai * 128 + wr * 64 + m * 16 + fr; const float rs = rs8[ai][m];
                float s1 = 0.f, s2 = 0.f;
#pragma unroll
                for (int bj = 0; bj < 2; ++bj) {
                    const int col = u.pn * 256 + bj * 128 + wc * 32 + 8 * fq;
                    f32x4 v0 = acc[ai][bj][m][0] * rs, v1 = acc[ai][bj][m][1] * rs;
                    { const f32x2 a = pg8::gelu_pk((f32x2){v0[0], v0[1]}), b = pg8::gelu_pk((f32x2){v0[2], v0[3]}), cc = pg8::gelu_pk((f32x2){v1[0], v1[1]}), d = pg8::gelu_pk((f32x2){v1[2], v1[3]});
                      v0 = (f32x4){a.x, a.y, b.x, b.y}; v1 = (f32x4){cc.x, cc.y, d.x, d.y}; }
                    if (u.pn < 8) {
                        u32x4 w; w.x = cvt_pk_bf16(v0[0], v0[1]); w.y = cvt_pk_bf16(v0[2], v0[3]); w.z = cvt_pk_bf16(v1[0], v1[1]); w.w = cvt_pk_bf16(v1[2], v1[3]);
                        st16(U2 + (size_t)row * SGW + col, w);
                    } else {
                        u32x4 w; w.x = cvt_pk_bf16(v0[0], v0[1]); w.y = cvt_pk_bf16(v0[2], v0[3]); w.z = cvt_pk_bf16(v1[0], v1[1]); w.w = cvt_pk_bf16(v1[2], v1[3]); st16(VPRE + (size_t)row * SGW + (col - SGW), w);
                        s1 += (v0[0] + v0[1]) + (v0[2] + v0[3]) + (v1[0] + v1[1]) + (v1[2] + v1[3]);
                        s2 += (v0[0] * v0[0] + v0[1] * v0[1]) + (v0[2] * v0[2] + v0[3] * v0[3]) + (v1[0] * v1[0] + v1[1] * v1[1]) + (v1[2] * v1[2] + v1[3] * v1[3]);
                    }
                }
                if (u.pn >= 8) {
                    s1 += __shfl_xor(s1, 16); s1 += __shfl_xor(s1, 32); s2 += __shfl_xor(s2, 16); s2 += __shfl_xor(s2, 32);
                    if (fq == 0) { float* lp = LNP + ((size_t)row * 32 + (u.pn - 8) * 4 + wc) * 2; lp[0] = s1; lp[1] = s2; }
                }
            }
    }
};

__device__ __forceinline__ f32x4 mfma16(bf16x8 a, bf16x8 b, f32x4 cc) { return __builtin_amdgcn_mfma_f32_16x16x32_bf16(a, b, cc, 0, 0, 0); }
template <class Epi> __device__ __forceinline__ void skinny_gemm(const Ctx& c, const bf16_t* A, const bf16_t* Bt, int K, int N, const Epi& E) {
    LAS float* red = (LAS float*)c.lds;
    const int ntask = 8 * (N >> 6), lane = c.lane, wv = c.wave, fr = lane & 15, fq = lane >> 4, kw = K >> 3;
    int it = 0;
    for (int t = c.bid; t < ntask; t += c.G, ++it) {
        const int rb = t & 7, cg = t >> 3, row = MP + rb * 16 + fr;
        LAS float* rbuf = red + (it & 1) * 8192;
        float rs = 1.0f; f32x4 pre[4];
#pragma unroll
        for (int nf = 0; nf < 4; ++nf) pre[nf] = (f32x4){0.f, 0.f, 0.f, 0.f};
        if (wv == 0) { rs = E.sk_scale(row);
#pragma unroll
            for (int nf = 0; nf < 4; ++nf) pre[nf] = E.sk_pre(row, cg * 64 + nf * 16 + fq * 4); }
        const bf16_t* ap = A + (size_t)row * K + wv * kw + fq * 8;
        const bf16_t* bp = Bt + (size_t)(cg * 64 + fr) * K + wv * kw + fq * 8;
        f32x4 acc[4];
#pragma unroll
        for (int nf = 0; nf < 4; ++nf) acc[nf] = (f32x4){0.f, 0.f, 0.f, 0.f};
#pragma unroll 1
        for (int k = 0; k < kw; k += 128) {
            bf16x8 af[4], bfr[4][4];
#pragma unroll
            for (int q = 0; q < 4; ++q) {
                af[q] = *(const bf16x8*)(ap + k + q * 32);
#pragma unroll
                for (int nf = 0; nf < 4; ++nf) bfr[q][nf] = *(const bf16x8*)(bp + (size_t)nf * 16 * K + k + q * 32);
            }
            __builtin_amdgcn_sched_barrier(0);
#pragma unroll
            for (int q = 0; q < 4; ++q)
#pragma unroll
                for (int nf = 0; nf < 4; ++nf) acc[nf] = mfma16(bfr[q][nf], af[q], acc[nf]);
        }
#pragma unroll
        for (int nf = 0; nf < 4; ++nf) *(LAS f32x4*)(rbuf + (wv * 64 + lane) * 16 + nf * 4) = acc[nf];
        LDS_BARRIER();
        if (wv == 0) {
            float s1 = 0.f, s2 = 0.f;
#pragma unroll
            for (int nf = 0; nf < 4; ++nf) {
                f32x4 v = *(const LAS f32x4*)(rbuf + lane * 16 + nf * 4);
#pragma unroll
                for (int w = 1; w < 8; ++w) v += *(const LAS f32x4*)(rbuf + (w * 64 + lane) * 16 + nf * 4);
                E.sk_elem(row, cg * 64 + nf * 16 + fq * 4, v, pre[nf], rs, s1, s2);
            }
            s1 += __shfl_xor(s1, 16); s1 += __shfl_xor(s1, 32); s2 += __shfl_xor(s2, 16); s2 += __shfl_xor(s2, 32);
            if (fq == 0) E.sk_fin(row, cg, s1, s2);
        }
    }
    LDS_BARRIER();
}
#define XB_TMO      128
#define XB_XCNT(j)  (256  + 64 * (j))
#define XB_XSUB(j)  (1280 + 64 * (j))
#define XB_XGEN(j)  (2304 + 64 * (j))
#define XB_TOP      3328
#define XB_TOPGEN   3392
#define XCD_BAR_WORDS 3456
#define XB_SPIN_CAP (1u << 18)

__device__ __forceinline__ unsigned xb_ld(unsigned* p)              { return __hip_atomic_load(p, __ATOMIC_RELAXED, __HIP_MEMORY_SCOPE_AGENT); }
__device__ __forceinline__ unsigned xb_add(unsigned* p, unsigned v) { return __hip_atomic_fetch_add(p, v, __ATOMIC_RELAXED, __HIP_MEMORY_SCOPE_AGENT); }
__device__ __forceinline__ unsigned xb_xcc_id() { return (unsigned)__builtin_amdgcn_s_getreg((3 << 11) | 20) & 0xFu; }
#define XB_SPIN(cond, bar) do { unsigned _sp = 0; while (cond) { __builtin_amdgcn_s_sleep(1); \
    if ((++_sp & 255u) == 0u) { if (xb_ld(&(bar)[XB_TMO])) break; if (_sp > XB_SPIN_CAP) { atomicAdd(&(bar)[XB_TMO], 1u); break; } } } } while (0)

struct XcdBarrier {
    unsigned* bar; unsigned x;
    volatile LAS unsigned* st;
};

__device__ __forceinline__ XcdBarrier xcd_barrier_post(unsigned* bar, volatile LAS unsigned* st) {
    XcdBarrier b; b.bar = bar; b.x = xb_xcc_id(); b.st = st;
    if (threadIdx.x == 0) (void)xb_add(&bar[XB_XCNT(b.x)], 1u);
    return b;
}
__device__ __forceinline__ void xcd_barrier_complete(unsigned* bar, unsigned x, unsigned& nloc, unsigned& nx) {
    const unsigned G = gridDim.x * gridDim.y * gridDim.z;
    unsigned sum, cnt, mine, sp = 0u;
    for (;;) {
        sum = 0u; cnt = 0u; mine = 0u;
#pragma unroll
        for (unsigned j = 0; j < 16; ++j) { const unsigned c = xb_ld(&bar[XB_XCNT(j)]); sum += c; cnt += (c > 0u) ? 1u : 0u; mine = (j == x) ? c : mine; }
        if (sum == G) break;
        __builtin_amdgcn_s_sleep(1);
        if ((++sp & 255u) == 0u) { if (xb_ld(&bar[XB_TMO])) break; if (sp > XB_SPIN_CAP) { atomicAdd(&bar[XB_TMO], 1u); break; } }
    }
    nloc = mine > 0u ? mine : 1u; nx = cnt > 0u ? cnt : 1u;
}

__device__ __forceinline__ void xcd_barrier(const XcdBarrier& b) {
    asm volatile("s_waitcnt vmcnt(0)" ::: "memory");
    __syncthreads();
    if (threadIdx.x == 0) {
        unsigned* bar = b.bar;
        __builtin_amdgcn_s_waitcnt(0);
        unsigned nloc = b.st[0], nx = b.st[1];
        if (nloc == 0u) { xcd_barrier_complete(bar, b.x, nloc, nx); b.st[0] = nloc; b.st[1] = nx; }
        const unsigned old = xb_add(&bar[XB_XSUB(b.x)], 1u);
        const unsigned gen = old / nloc;
        if (old + 1u == (gen + 1u) * nloc) {
            __builtin_amdgcn_fence(__ATOMIC_RELEASE, "agent");
            asm volatile("s_waitcnt vmcnt(0)" ::: "memory");
            const unsigned og = xb_add(&bar[XB_TOP], 1u);
            const unsigned tg = og / nx;
            if (og + 1u == (tg + 1u) * nx) xb_add(&bar[XB_TOPGEN], 1u);
            else XB_SPIN(xb_ld(&bar[XB_TOPGEN]) == tg, bar);
            __builtin_amdgcn_fence(__ATOMIC_ACQUIRE, "agent");
            xb_add(&bar[XB_XGEN(b.x)], 1u);
            asm volatile("s_waitcnt vmcnt(0)" ::: "memory");
        } else {
            XB_SPIN(xb_ld(&bar[XB_XGEN(b.x)]) == gen, bar);
            __builtin_amdgcn_fence(__ATOMIC_ACQUIRE, "agent");
            asm volatile("s_waitcnt vmcnt(0)" ::: "memory");
        }
    }
    __syncthreads();
}


constexpr int DA_PITCH = 520, LA_PITCH = 264;
#define ZL4(ptr) EpiRes::cvt4(*(const u32x2*)(ptr))
__device__ __forceinline__ void phase_pool_prep_impl(const Ctx& c, const bf16_t* __restrict__ Z, bf16_t* __restrict__ CAT, float* __restrict__ SC, float* __restrict__ GATE, float* __restrict__ outp) {
    const bf16_t* POOLWT = WSP(bf16_t, OFF_POOLWT); const bf16_t* W2T = WSP(bf16_t, OFF_W2T); const bf16_t* A2T = WSP(bf16_t, OFF_A2T); const bf16_t* G2T = WSP(bf16_t, OFF_G2T);
    const float* state_pool = c.in[5]; const float* state_shift = c.in[6];
    const float* pool_scale = c.in[16]; const float* mu = c.in[17]; const float* w0 = c.in[18]; const float* a0 = c.in[20];
    const float* k_k = c.in[23]; const float* k_a = c.in[24];
    LAS bf16_t* dA = (LAS bf16_t*)c.lds;
    LAS bf16_t* LA = (LAS bf16_t*)(c.lds + 32 * DA_PITCH * 2);
    const int tid = c.tid, lane = c.lane, wv = c.wave, fr = lane & 15, fq = lane >> 4;
    LAS float* PAR = (LAS float*)(c.lds + 32 * DA_PITCH * 2 + 32 * LA_PITCH * 2);
    for (int i = tid; i < 3840; i += 512) PAR[i] = i < 1792 ? mu[i] : (i < 2304 ? k_k[i - 1792] : (i < 2816 ? a0[i - 2304] : (i < 3328 ? w0[i - 2816] : k_a[i - 3328])));
    LDS_BARRIER();
    for (int tile = c.bid; tile < MP / 32 + MS / 16; tile += c.G) {
        const bool samp = tile >= MP / 32; const int R0 = samp ? MP + (tile - MP / 32) * 16 : tile * 32; const int nmf = samp ? 1 : 2;
        {
            const int cgi = tid & 127, rp = tid >> 7, col = cgi * 4, gi = cgi >> 5, w = 2 << gi;
            if (!samp) {
                const int r0 = R0 + rp * 8, pos0 = r0 & (SEQ - 1);
                f32x4 t[23];
#pragma unroll
                for (int j = 0; j < 23; ++j) {
                    const bool need = (j >= 16 - w) && (pos0 - 15 + j >= 0);
                    t[j] = need ? ZL4(Z + (size_t)(r0 - 15 + j) * ABIN + col) : (f32x4){0.f, 0.f, 0.f, 0.f};
                }
#pragma unroll
                for (int rr = 0; rr < 8; ++rr) {
                    const int R = r0 + rr, pos = pos0 + rr;
                    f32x4 s = t[15 + rr];
#pragma unroll
                    for (int i = 1; i < 16; ++i) if (i < w) s += t[15 + rr - i];
                    const int np = pos < (w - 1) ? pos : (w - 1);
                    const f32x4 zc = t[15 + rr];
                    if (pos >= SEQ - 15) *(f32x4*)(outp + O_PP + ((size_t)(R >> 11) * 15 + (pos - (SEQ - 15))) * PW + col) = zc;
                    const f32x4 d = s * (1.0f / (float)(np + 1)) - zc;
                    u32x2 pk; pk.x = cvt_pk_bf16(d[0], d[1]); pk.y = cvt_pk_bf16(d[2], d[3]);
                    *(LAS u32x2*)(dA + (rp * 8 + rr) * DA_PITCH + col) = pk;
                }
            } else if (rp < 2) {
                for (int rr = 0; rr < 8; ++rr) {
                    const int r = rp * 8 + rr, R = R0 + r, b = R - MP;
                    const f32x4 zc = ZL4(Z + (size_t)R * ABIN + col);
                    f32x4 hb[15];
#pragma unroll
                    for (int j = 0; j < 15; ++j) hb[j] = *(const f32x4*)(state_pool + ((size_t)b * 15 + j) * PW + col);
                    f32x4 s = zc;
#pragma unroll
                    for (int i = 1; i < 16; ++i) if (i < w) s += hb[15 - i];
                    const f32x4 d = s * (1.0f / (float)w) - zc;
                    u32x2 pk; pk.x = cvt_pk_bf16(d[0], d[1]); pk.y = cvt_pk_bf16(d[2], d[3]);
                    *(LAS u32x2*)(dA + r * DA_PITCH + col) = pk;
                }
            }
        }
        if ((tid >> 4) < nmf * 16) {
            const int r = tid >> 4, c0 = (tid & 15) * 16, R = R0 + r;
            const bf16_t* zc = Z + (size_t)R * ABIN + PW + 1536 + c0;
            const bool hasp = samp || (R & (SEQ - 1)) != 0;
            const bf16_t* zp = Z + (size_t)(R - (hasp && !samp ? 1 : 0)) * ABIN + PW + 1536 + c0;
            const float* zpf = state_shift + (size_t)(samp ? R - MP : 0) * RIN + 1536 + c0;
            float f[16];
#pragma unroll
            for (int q = 0; q < 4; ++q) {
                const f32x4 a = ZL4(zc + q * 4); f32x4 p = samp ? *(const f32x4*)(zpf + q * 4) : ZL4(zp + q * 4); const f32x4 m4 = *(const LAS f32x4*)(PAR + 1536 + c0 + q * 4);
                if (!hasp) p = (f32x4){0.f, 0.f, 0.f, 0.f};
                const f32x4 zs = a + (p - a) * m4;
#pragma unroll
                for (int e = 0; e < 4; ++e) f[q * 4 + e] = c0 < 64 ? tanhf_(zs[e]) : (c0 < 128 ? zs[e] : sigmoidf_(zs[e]));
            }
            u32x4 w0_, w1_;
            w0_.x = cvt_pk_bf16(f[0], f[1]); w0_.y = cvt_pk_bf16(f[2], f[3]); w0_.z = cvt_pk_bf16(f[4], f[5]); w0_.w = cvt_pk_bf16(f[6], f[7]);
            w1_.x = cvt_pk_bf16(f[8], f[9]); w1_.y = cvt_pk_bf16(f[10], f[11]); w1_.z = cvt_pk_bf16(f[12], f[13]); w1_.w = cvt_pk_bf16(f[14], f[15]);
            *(LAS u32x4*)(LA + r * LA_PITCH + c0) = w0_; *(LAS u32x4*)(LA + r * LA_PITCH + c0 + 8) = w1_;
            if (!samp) {
                if (((R0 + 31) & (SEQ - 1)) == SEQ - 1 && tid < RIN / 4)
                    *(f32x4*)(outp + O_SHP + (size_t)(R0 >> 11) * RIN + tid * 4) = ZL4(Z + (size_t)(R0 + 31) * ABIN + PW + tid * 4);
            }
        }
        LDS_BARRIER();
        {
            const int gi = wv >> 1, nh = wv & 1;
            f32x4 acc[2][4];
#pragma unroll
            for (int a = 0; a < 2; ++a)
#pragma unroll
                for (int b = 0; b < 4; ++b) acc[a][b] = (f32x4){0.f, 0.f, 0.f, 0.f};
            {
                bf16x8 bw[4][4];
#pragma unroll
                for (int ks = 0; ks < 4; ++ks)
#pragma unroll
                    for (int nf = 0; nf < 4; ++nf) bw[ks][nf] = *(const bf16x8*)(POOLWT + ((size_t)(gi * 128 + nh * 64 + nf * 16 + fr)) * 128 + ks * 32 + fq * 8);
                __builtin_amdgcn_sched_barrier(0);
#pragma unroll
                for (int ks = 0; ks < 4; ++ks) {
                    bf16x8 af[2];
#pragma unroll
                    for (int mf = 0; mf < 2; ++mf) af[mf] = *(const LAS bf16x8*)(dA + (mf * 16 + fr) * DA_PITCH + gi * 128 + ks * 32 + fq * 8);
#pragma unroll
                    for (int nf = 0; nf < 4; ++nf)
#pragma unroll
                        for (int mf = 0; mf < 2; ++mf) acc[mf][nf] = mfma16(bw[ks][nf], af[mf], acc[mf][nf]);
                }
            }
            __builtin_amdgcn_sched_barrier(0);
#pragma unroll
            for (int mf = 0; mf < 2; ++mf)
#pragma unroll
                for (int nf = 0; nf < 4; ++nf) if (mf < nmf) {
                    const int R = R0 + mf * 16 + fr, co = gi * 128 + nh * 64 + nf * 16 + fq * 4;
                    const f32x4 sc = *(const f32x4*)(pool_scale + co); const f32x4 v = acc[mf][nf] * sc;
                    u32x2 pk; pk.x = cvt_pk_bf16(v[0], v[1]); pk.y = cvt_pk_bf16(v[2], v[3]);
                    *(u32x2*)(CAT + (size_t)R * DM + co) = pk;
                }
        }
        __builtin_amdgcn_sched_barrier(0);
        {
            const int h = wv;
#pragma unroll 1
            for (int mf = 0; mf < nmf; ++mf) {
                f32x4 aw[4], aa[4];
#pragma unroll
                for (int b = 0; b < 4; ++b) { aw[b] = (f32x4){0.f, 0.f, 0.f, 0.f}; aa[b] = aw[b]; }
                {
                    bf16x8 bw[2][4], ba[2][4];
#pragma unroll
                    for (int ks = 0; ks < 2; ++ks)
#pragma unroll
                        for (int nf = 0; nf < 4; ++nf) {
                            bw[ks][nf] = *(const bf16x8*)(W2T + (size_t)(h * 64 + nf * 16 + fr) * 64 + ks * 32 + fq * 8);
                            ba[ks][nf] = *(const bf16x8*)(A2T + (size_t)(h * 64 + nf * 16 + fr) * 64 + ks * 32 + fq * 8);
                        }
                    __builtin_amdgcn_sched_barrier(0);
#pragma unroll
                    for (int ks = 0; ks < 2; ++ks) {
                        const bf16x8 af = *(const LAS bf16x8*)(LA + (mf * 16 + fr) * LA_PITCH + ks * 32 + fq * 8);
                        const bf16x8 ag_ = *(const LAS bf16x8*)(LA + (mf * 16 + fr) * LA_PITCH + 64 + ks * 32 + fq * 8);
#pragma unroll
                        for (int nf = 0; nf < 4; ++nf) { aw[nf] = mfma16(bw[ks][nf], af, aw[nf]); aa[nf] = mfma16(ba[ks][nf], ag_, aa[nf]); }
                    }
                }
                __builtin_amdgcn_sched_barrier(0);
                const int R = R0 + mf * 16 + fr;
                const bf16_t* zc = Z + (size_t)R * ABIN + PW;
                const bool hasp = samp || (R & (SEQ - 1)) != 0;
                const bf16_t* zp = Z + (size_t)(R - (hasp && !samp ? 1 : 0)) * ABIN + PW;
                const float* zpf = state_shift + (size_t)(samp ? R - MP : 0) * RIN;
#define ZLOAD4(dst, base) do { f32x4 a_[4], p_[4]; \
                    _Pragma("unroll") for (int nf = 0; nf < 4; ++nf) { const int cx = (base) + h * 64 + nf * 16 + fq * 4; a_[nf] = ZL4(zc + cx); p_[nf] = samp ? *(const f32x4*)(zpf + cx) : ZL4(zp + cx); } \
                    _Pragma("unroll") for (int nf = 0; nf < 4; ++nf) { const int cx = (base) + h * 64 + nf * 16 + fq * 4; if (!hasp) p_[nf] = (f32x4){0.f, 0.f, 0.f, 0.f}; \
                        dst[nf] = a_[nf] + (p_[nf] - a_[nf]) * *(const LAS f32x4*)(PAR + cx); } } while (0)
                f32x4 k4[4], kk4[4], r4[4], v4[4]; float ss = 0.f;
                ZLOAD4(k4, 512);
                __builtin_amdgcn_sched_barrier(0);
                ZLOAD4(r4, 0);
                __builtin_amdgcn_sched_barrier(0);
                ZLOAD4(v4, 1024);
                __builtin_amdgcn_sched_barrier(0);
#pragma unroll
                for (int nf = 0; nf < 4; ++nf) {
                    kk4[nf] = k4[nf] * *(const LAS f32x4*)(PAR + 1792 + h * 64 + nf * 16 + fq * 4);
                    ss += (kk4[nf][0] * kk4[nf][0] + kk4[nf][1] * kk4[nf][1]) + (kk4[nf][2] * kk4[nf][2] + kk4[nf][3] * kk4[nf][3]);
                }
                ss += __shfl_xor(ss, 16); ss += __shfl_xor(ss, 32);
                const float inv = 1.0f / fmaxf(sqrtf(ss), 1e-12f);
                float* scb = SC + ((size_t)(R >> 4) * 8 + h) * 6144 + (R & 15) * 16 + fq * 4;
#pragma unroll
                for (int nf = 0; nf < 4; ++nf) {
                    const int off = nf * 16 + fq * 4;
                    const f32x4 a0v = *(const LAS f32x4*)(PAR + 2304 + h * 64 + off), w0v = *(const LAS f32x4*)(PAR + 2816 + h * 64 + off), kav = *(const LAS f32x4*)(PAR + 3328 + h * 64 + off);
                    f32x4 a4, dec;
#pragma unroll
                    for (int e = 0; e < 4; ++e) { a4[e] = sigmoidf_(a0v[e] + aa[nf][e]); dec[e] = __expf(-0.6065306597126334f * sigmoidf_(w0v[e] + aw[nf][e])); }
                    const f32x4 kkn = kk4[nf] * inv, kp = k4[nf] * (1.0f + (a4 - 1.0f) * kav);
                    *(f32x4*)(scb + nf * 256) = -kkn; *(f32x4*)(scb + 1024 + nf * 256) = dec; *(f32x4*)(scb + 2048 + nf * 256) = kkn * a4;
                    *(f32x4*)(scb + 3072 + nf * 256) = kp; *(f32x4*)(scb + 4096 + nf * 256) = r4[nf]; *(f32x4*)(scb + 5120 + nf * 256) = v4[nf];
                }
#undef ZLOAD4
            }
            {
                f32x4 ag[2][4];
#pragma unroll
                for (int a = 0; a < 2; ++a)
#pragma unroll
                    for (int b = 0; b < 4; ++b) ag[a][b] = (f32x4){0.f, 0.f, 0.f, 0.f};
                {
                    bf16x8 bg[4][4];
#pragma unroll
                    for (int ks = 0; ks < 4; ++ks)
#pragma unroll
                        for (int nf = 0; nf < 4; ++nf) bg[ks][nf] = *(const bf16x8*)(G2T + (size_t)(h * 64 + nf * 16 + fr) * 128 + ks * 32 + fq * 8);
                    __builtin_amdgcn_sched_barrier(0);
#pragma unroll
                    for (int ks = 0; ks < 4; ++ks) {
                        bf16x8 af[2];
#pragma unroll
                        for (int mf = 0; mf < 2; ++mf) af[mf] = *(const LAS bf16x8*)(LA + (mf * 16 + fr) * LA_PITCH + 128 + ks * 32 + fq * 8);
#pragma unroll
                        for (int nf = 0; nf < 4; ++nf)
#pragma unroll
                            for (int mf = 0; mf < 2; ++mf) ag[mf][nf] = mfma16(bg[ks][nf], af[mf], ag[mf][nf]);
                    }
                }
#pragma unroll
                for (int mf = 0; mf < 2; ++mf)
#pragma unroll
                    for (int nf = 0; nf < 4; ++nf) if (mf < nmf) *(f32x4*)(GATE + (size_t)(R0 + mf * 16 + fr) * 512 + h * 64 + nf * 16 + fq * 4) = ag[mf][nf];
            }
        }
        LDS_BARRIER();
    }
}

__device__ __forceinline__ void phase_pool_prep(const Ctx& c) { phase_pool_prep_impl(c, WSP(bf16_t, OFF_Z), WSP(bf16_t, OFF_CAT), WSP(float, OFF_SC), WSP(float, OFF_GATE), c.out); }

__device__ __forceinline__ float rowsum16(float x) {
    x += __builtin_bit_cast(float, __builtin_amdgcn_update_dpp(0, __builtin_bit_cast(int, x), 0x128, 0xf, 0xf, false));
    x += __builtin_bit_cast(float, __builtin_amdgcn_update_dpp(0, __builtin_bit_cast(int, x), 0x124, 0xf, 0xf, false));
    x += __builtin_bit_cast(float, __builtin_amdgcn_update_dpp(0, __builtin_bit_cast(int, x), 0x122, 0xf, 0xf, false));
    x += __builtin_bit_cast(float, __builtin_amdgcn_update_dpp(0, __builtin_bit_cast(int, x), 0x121, 0xf, 0xf, false));
    return x;
}
constexpr int SCAN_CH = 32;
__device__ __forceinline__ void phase_scan(const Ctx& c) {
    const float* SC = WSP(float, OFF_SC); float* YR = WSP(float, OFF_YR);
    LAS float* buf = (LAS float*)c.lds;
    const int tid = c.tid, lane = c.lane, wv = c.wave;
    for (int ub = c.bid; ub < 256; ub += c.G) {
        const int unit = (c.G == 256) ? ((ub & 7) * 32 + (ub >> 3)) : ub;
        const int bh = unit >> 2, rg = unit & 3, b = bh >> 3, h = bh & 7;
        const float* src = SC + ((size_t)(b * (SEQ / 16)) * 8 + h) * 6144;
#define SC_DEC(idx_, rbi_, arr_, nf_, fr_, q4_) const int rbi_ = (idx_) / 1536, rem_##idx_ = (idx_) % 1536, arr_ = rem_##idx_ >> 8, nf_ = (rem_##idx_ >> 6) & 3, fr_ = (rem_##idx_ >> 2) & 15, q4_ = rem_##idx_ & 3
        const int v = rg * 16 + (wv & 3) * 4 + (lane >> 4), k0 = (lane & 15) * 4;
        f32x4 S = (f32x4){0.f, 0.f, 0.f, 0.f}; float ykeep = 0.f;
        if (wv >= 4) {
            const int lt = tid - 256;
#pragma unroll
            for (int i = 0; i < 12; ++i) { const int idx = lt + i * 256; SC_DEC(idx, rbi, arr, nf, fr2, q4);
                *(LAS f32x4*)(buf + (rbi * 16 + fr2) * 384 + arr * 64 + nf * 16 + q4 * 4) = *(const f32x4*)(src + (size_t)rbi * 49152 + (size_t)(idx % 1536) * 4); }
        }
        LDS_BARRIER();
        for (int ch = 0; ch < SEQ / SCAN_CH; ++ch) {
            if (wv >= 4) {
                if (ch + 1 < SEQ / SCAN_CH) {
                    const int lt = tid - 256; LAS float* bb = buf + ((ch + 1) & 1) * (SCAN_CH * 384);
                    f32x4 t[12];
#pragma unroll
                    for (int i = 0; i < 12; ++i) { const int idx = lt + i * 256; t[i] = *(const f32x4*)(src + (size_t)((ch + 1) * 2 + idx / 1536) * 49152 + (size_t)(idx % 1536) * 4); }
#pragma unroll
                    for (int i = 0; i < 12; ++i) { const int idx = lt + i * 256; SC_DEC(idx, rbi, arr, nf, fr2, q4); *(LAS f32x4*)(bb + (rbi * 16 + fr2) * 384 + arr * 64 + nf * 16 + q4 * 4) = t[i]; }
                }
            } else {
                const LAS float* bb = buf + (ch & 1) * (SCAN_CH * 384);
                f32x4 pn[3][5]; float pv[3];
#define SCAN_LD(slot, s_) do { const LAS float* p_ = bb + (s_) * 384; pn[slot][0] = *(const LAS f32x4*)(p_ + k0); pn[slot][1] = *(const LAS f32x4*)(p_ + 64 + k0); \
                    pn[slot][2] = *(const LAS f32x4*)(p_ + 128 + k0); pn[slot][3] = *(const LAS f32x4*)(p_ + 192 + k0); pn[slot][4] = *(const LAS f32x4*)(p_ + 256 + k0); pv[slot] = p_[320 + v]; } while (0)
                SCAN_LD(0, 0); SCAN_LD(1, 1);
#pragma unroll
                for (int s = 0; s < SCAN_CH; ++s) {
                    if (s + 2 < SCAN_CH) SCAN_LD((s + 2) % 3, s + 2);
                    const f32x4 nkk = pn[s % 3][0], d = pn[s % 3][1], ka = pn[s % 3][2], kp = pn[s % 3][3], r = pn[s % 3][4];
                    const float vv = pv[s % 3];
                    const float sa = rowsum16((S[0] * nkk[0] + S[1] * nkk[1]) + (S[2] * nkk[2] + S[3] * nkk[3]));
                    S = S * d + ka * sa + kp * vv;
                    const float y = rowsum16((S[0] * r[0] + S[1] * r[1]) + (S[2] * r[2] + S[3] * r[3]));
                    ykeep = ((s & 15) == (lane & 15)) ? y : ykeep;
                    if ((s & 15) == 15) YR[((size_t)b * SEQ + ch * SCAN_CH + (s - 15) + (lane & 15)) * 512 + h * 64 + v] = ykeep;
                }
#undef SCAN_LD
            }
            LDS_BARRIER();
        }
        if (wv < 4) *(f32x4*)(c.out + O_WKP + (((size_t)b * 8 + h) * 64 + v) * 64 + k0) = S;
    }
    const float* swkv = c.in[7];
    for (int unit = c.bid; unit < MS * 8; unit += c.G) {
        const int b = unit >> 3, h = unit & 7, v = tid >> 3, k0 = (tid & 7) * 8;
        const size_t so = (((size_t)b * 8 + h) * 64 + v) * 64 + k0;
        f32x4 S0 = *(const f32x4*)(swkv + so), S1 = *(const f32x4*)(swkv + so + 4);
        const float* pb_ = SC + ((size_t)((MP + b) >> 4) * 8 + h) * 6144 + ((MP + b) & 15) * 16;
        const float* p = pb_ + (k0 >> 4) * 256 + (k0 & 15);
        const f32x4 n0 = *(const f32x4*)(p), n1 = *(const f32x4*)(p + 4), d0 = *(const f32x4*)(p + 1024), d1 = *(const f32x4*)(p + 1024 + 4),
                    a0_ = *(const f32x4*)(p + 2048), a1_ = *(const f32x4*)(p + 2048 + 4), kp0 = *(const f32x4*)(p + 3072), kp1 = *(const f32x4*)(p + 3072 + 4),
                    r0 = *(const f32x4*)(p + 4096), r1 = *(const f32x4*)(p + 4096 + 4);
        const float vv = pb_[5120 + (v >> 4) * 256 + (v & 15)];
        float sa = (S0[0] * n0[0] + S0[1] * n0[1]) + (S0[2] * n0[2] + S0[3] * n0[3]) + (S1[0] * n1[0] + S1[1] * n1[1]) + (S1[2] * n1[2] + S1[3] * n1[3]);
        sa += __shfl_xor(sa, 1); sa += __shfl_xor(sa, 2); sa += __shfl_xor(sa, 4);
        S0 = S0 * d0 + a0_ * sa + kp0 * vv; S1 = S1 * d1 + a1_ * sa + kp1 * vv;
        float y = (S0[0] * r0[0] + S0[1] * r0[1]) + (S0[2] * r0[2] + S0[3] * r0[3]) + (S1[0] * r1[0] + S1[1] * r1[1]) + (S1[2] * r1[2] + S1[3] * r1[3]);
        y += __shfl_xor(y, 1); y += __shfl_xor(y, 2); y += __shfl_xor(y, 4);
        *(f32x4*)(c.out + O_WKS + so) = S0; *(f32x4*)(c.out + O_WKS + so + 4) = S1;
        if ((tid & 7) == 0) YR[(size_t)(MP + b) * 512 + h * 64 + v] = y;
    }
}

__device__ __forceinline__ void phase_post(const Ctx& c) {
    const float* SC = WSP(float, OFF_SC); const float* YR = WSP(float, OFF_YR); const float* GATE = WSP(float, OFF_GATE); bf16_t* CAT = WSP(bf16_t, OFF_CAT);
    const float* r_k = c.in[25]; const float* gn_g = c.in[26]; const float* gn_b = c.in[27];
    const int gw = c.bid * 8 + c.wave, nw = c.G * 8, l16 = c.lane & 15, hq = c.lane >> 4;
    for (int t = gw; t < MR * 2; t += nw) {
        const int R = t >> 1, h = (t & 1) * 4 + hq, cc = h * 64 + l16 * 4;
        const float* p = SC + ((size_t)(R >> 4) * 8 + h) * 6144 + (l16 >> 2) * 256 + (R & 15) * 16 + (l16 & 3) * 4;
        const f32x4 y = *(const f32x4*)(YR + (size_t)R * 512 + cc), kp = *(const f32x4*)(p + 3072), r = *(const f32x4*)(p + 4096), v = *(const f32x4*)(p + 5120);
        const f32x4 g = *(const f32x4*)(GATE + (size_t)R * 512 + cc), rk = *(const f32x4*)(r_k + cc), gg = *(const f32x4*)(gn_g + cc), gb = *(const f32x4*)(gn_b + cc);
        const float m = rowsum16((y[0] + y[1]) + (y[2] + y[3])) * (1.0f / 64.0f);
        const f32x4 dl = y - m;
        const float var = rowsum16((dl[0] * dl[0] + dl[1] * dl[1]) + (dl[2] * dl[2] + dl[3] * dl[3])) * (1.0f / 64.0f);
        const float bs = rowsum16((r[0] * kp[0] * rk[0] + r[1] * kp[1] * rk[1]) + (r[2] * kp[2] * rk[2] + r[3] * kp[3] * rk[3]));
        const f32x4 o = (dl * rsqrtf(var + GN_EPS) * gg + gb + v * bs) * g;
        u32x2 pk; pk.x = cvt_pk_bf16(o[0], o[1]); pk.y = cvt_pk_bf16(o[2], o[3]);
        *(u32x2*)(CAT + (size_t)R * DM + 512 + cc) = pk;
    }
}

__device__ __forceinline__ void phase_attn(const Ctx& c, int l, int amask = 3) {
    const bf16_t* Q = WSP(bf16_t, OFF_Q); bf16_t* OAT = WSP(bf16_t, OFF_OAT);
    const bf16_t* KB = WSP(bf16_t, OFF_KB) + (size_t)l * 2048 * 1024; const bf16_t* VT = WSP(bf16_t, OFF_VT) + (size_t)l * 2048 * 1024;
    const float* ck = c.in[3] + (size_t)l * MS * 256 * 1024; const float* cv = c.in[4] + (size_t)l * MS * 256 * 1024;
    const int tid = c.tid, lane = c.lane, wv = c.wave, fr = lane & 15, fq = lane >> 4;
    LAS float* sc = (LAS float*)(c.lds + 73728);
    LAS float* red = (LAS float*)(c.lds + 73728 + 1024);
    const int NPU = 512, NSU = 512;
    const int nround = (NPU + NSU + c.G - 1) / c.G; const bool rev = ((c.bid >> 3) & 1) != 0;
    for (int kk = 0; kk < nround; ++kk) {
        const int kq = (nround == 4) ? (((kk & 1) << 1) | (kk >> 1)) : kk;
        const int unit = c.bid + (rev ? nround - 1 - kq : kq) * c.G;
        if (unit >= NPU + NSU) continue;
        if (!((amask >> (unit >= NPU)) & 1)) continue;
        if (unit < NPU) {
            const int b = unit >> 6, h = (unit >> 4) & 3, qb = unit & 15;
            const int R0 = b * SEQ + qb * 128 + wv * 16;
            const bf16_t* kg = KB + (size_t)(b * 256) * DM + h * 256;
            const bf16_t* vg = VT + ((size_t)(b * 4 + h) * 256) * 256;
            bf16x8 qf[8];
#pragma unroll
            for (int ks = 0; ks < 8; ++ks) qf[ks] = *(const bf16x8*)(Q + (size_t)(R0 + fr) * DM + h * 256 + ks * 32 + fq * 8);
            u32x4 st[4];
#define ATT_LOAD(ti) do { _Pragma("unroll") for (int i = 0; i < 4; ++i) { const int q = tid + i * 512; \
                if ((ti) < 4) st[i] = *(const u32x4*)(kg + (size_t)((ti) * 64 + (q >> 5)) * DM + (q & 31) * 8); \
                else st[i] = *(const u32x4*)(vg + (size_t)(q >> 3) * 256 + ((ti) - 4) * 64 + (q & 7) * 8); } } while (0)
#define ATT_STORE(ti, bufp) do { _Pragma("unroll") for (int i = 0; i < 4; ++i) { const int q = tid + i * 512; \
                if ((ti) < 4) *(LAS u32x4*)((bufp) + (q >> 5) * 528 + (q & 31) * 16) = st[i]; \
                else *(LAS u32x4*)((bufp) + (q >> 3) * 144 + (q & 7) * 16) = st[i]; } } while (0)
            ATT_LOAD(0); ATT_STORE(0, c.lds);
            LDS_BARRIER();
            f32x4 s[16]; f32x4 o[16]; bf16x8 pf[8]; float inv = 1.f;
#pragma unroll
            for (int i = 0; i < 16; ++i) { s[i] = (f32x4){0.f, 0.f, 0.f, 0.f}; o[i] = (f32x4){0.f, 0.f, 0.f, 0.f}; }
#pragma unroll
            for (int ti = 0; ti < 8; ++ti) {
                LAS unsigned char* cur = c.lds + (ti & 1) * 36864; LAS unsigned char* nxt = c.lds + ((ti + 1) & 1) * 36864;
                if (ti + 1 < 8) ATT_LOAD(ti + 1);
                if (ti < 4) {
#pragma unroll
                    for (int n4 = 0; n4 < 4; ++n4)
#pragma unroll
                        for (int ks = 0; ks < 8; ++ks) {
                            const bf16x8 kf = *(const LAS bf16x8*)(cur + (n4 * 16 + fr) * 528 + (ks * 32 + fq * 8) * 2);
                            s[ti * 4 + n4] = mfma16(kf, qf[ks], s[ti * 4 + n4]);
                        }
                    if (ti == 3) {
                        float mx = -3.0e38f;
#pragma unroll
                        for (int nf = 0; nf < 16; ++nf) mx = fmaxf(mx, fmaxf(fmaxf(s[nf][0], s[nf][1]), fmaxf(s[nf][2], s[nf][3])));
                        mx = fmaxf(mx, __shfl_xor(mx, 16)); mx = fmaxf(mx, __shfl_xor(mx, 32));
                        float sum = 0.f;
#pragma unroll
                        for (int nf = 0; nf < 16; ++nf)
#pragma unroll
                            for (int e = 0; e < 4; ++e) { const float p = exp2f(s[nf][e] - mx); s[nf][e] = p; sum += p; }
                        sum += __shfl_xor(sum, 16); sum += __shfl_xor(sum, 32);
                        inv = 1.0f / sum;
#pragma unroll
                        for (int ks = 0; ks < 8; ++ks) {
                            u32x4 w; w.x = cvt_pk_bf16(s[2 * ks][0], s[2 * ks][1]); w.y = cvt_pk_bf16(s[2 * ks][2], s[2 * ks][3]);
                            w.z = cvt_pk_bf16(s[2 * ks + 1][0], s[2 * ks + 1][1]); w.w = cvt_pk_bf16(s[2 * ks + 1][2], s[2 * ks + 1][3]);
                            pf[ks] = __builtin_bit_cast(bf16x8, w);
                        }
                    }
                } else {
                    const int mt = ti - 4;
#pragma unroll
                    for (int nfd = 0; nfd < 16; ++nfd)
#pragma unroll
                        for (int kl = 0; kl < 2; ++kl) {
                            const LAS unsigned char* vp = cur + (nfd * 16 + fr) * 144 + (kl * 32 + fq * 4) * 2;
                            const u32x2 lo = *(const LAS u32x2*)vp, hi = *(const LAS u32x2*)(vp + 32);
                            u32x4 w; w.x = lo.x; w.y = lo.y; w.z = hi.x; w.w = hi.y;
                            o[nfd] = mfma16(__builtin_bit_cast(bf16x8, w), pf[2 * mt + kl], o[nfd]);
                        }
                }
                if (ti + 1 < 8) ATT_STORE(ti + 1, nxt);
                LDS_BARRIER();
            }
#undef ATT_LOAD
#undef ATT_STORE
#pragma unroll
            for (int nfd = 0; nfd < 16; ++nfd) {
                const f32x4 ov = o[nfd] * inv;
                u32x2 pk; pk.x = cvt_pk_bf16(ov[0], ov[1]); pk.y = cvt_pk_bf16(ov[2], ov[3]);
                *(u32x2*)(OAT + (size_t)(R0 + fr) * DM + h * 256 + nfd * 16 + fq * 4) = pk;
            }
        } else {
            const int su = unit - NPU, b = su >> 2, h = su & 3, R = MP + b;
            const int l16 = lane & 15, rj = lane >> 4;
            f32x4 q4[4];
#pragma unroll
            for (int i = 0; i < 4; ++i) { const u32x2 qraw = *(const u32x2*)(Q + (size_t)R * DM + h * 256 + (i * 16 + l16) * 4);
                q4[i] = (f32x4){__uint_as_float(qraw.x << 16), __uint_as_float(qraw.x & 0xffff0000u), __uint_as_float(qraw.y << 16), __uint_as_float(qraw.y & 0xffff0000u)}; }
            const float* kb = ck + ((size_t)b * 256 * 4 + h) * 256;
            const float* vbp = cv + ((size_t)b * 256 * 4 + h) * 256 + lane * 4;
#pragma unroll
            for (int gh = 0; gh < 2; ++gh) {
                f32x4 kv[4][4];
#pragma unroll
                for (int g = 0; g < 4; ++g)
#pragma unroll
                    for (int i = 0; i < 4; ++i) kv[g][i] = *(const f32x4*)(kb + (size_t)(wv * 32 + (gh * 4 + g) * 4 + rj) * 1024 + (i * 16 + l16) * 4);
#pragma unroll
                for (int g = 0; g < 4; ++g) {
                    float d = 0.f;
#pragma unroll
                    for (int i = 0; i < 4; ++i) d += (kv[g][i][0] * q4[i][0] + kv[g][i][1] * q4[i][1]) + (kv[g][i][2] * q4[i][2] + kv[g][i][3] * q4[i][3]);
                    d = rowsum16(d);
                    if (l16 == 0) sc[wv * 32 + (gh * 4 + g) * 4 + rj] = d;
                }
            }
            LDS_BARRIER();
            const f32x4 s4 = *(const LAS f32x4*)(sc + lane * 4);
            const float mx = wave_max(fmaxf(fmaxf(s4[0], s4[1]), fmaxf(s4[2], s4[3])));
            const float sum = wave_sum((exp2f(s4[0] - mx) + exp2f(s4[1] - mx)) + (exp2f(s4[2] - mx) + exp2f(s4[3] - mx)));
            f32x4 acc = (f32x4){0.f, 0.f, 0.f, 0.f};
            for (int mi = 0; mi < 32; mi += 16) {
                f32x4 vv[16];
#pragma unroll
                for (int e = 0; e < 16; ++e) vv[e] = *(const f32x4*)(vbp + (size_t)(wv * 32 + mi + e) * 1024);
#pragma unroll
                for (int e = 0; e < 16; ++e) { const float p = exp2f(sc[wv * 32 + mi + e] - mx); acc += vv[e] * p; }
            }
            *(LAS f32x4*)(red + wv * 256 + lane * 4) = acc;
            LDS_BARRIER();
            if (tid < 256) {
                float o = 0.f;
#pragma unroll
                for (int w = 0; w < 8; ++w) o += red[w * 256 + tid];
                OAT[(size_t)R * DM + h * 256 + tid] = (bf16_t)cvt_pk_bf16(o / sum, 0.f);
            }
            LDS_BARRIER();
        }
    }
}

constexpr int SP_PITCH = 132;
__device__ __forceinline__ void phase_spatial(const Ctx& c) {
    const bf16_t* VPRE = WSP(bf16_t, OFF_VPRE); const float* LNP = WSP(float, OFF_LNP); const bf16_t* U2 = WSP(bf16_t, OFF_U2); bf16_t* G2 = WSP(bf16_t, OFF_G2);
    const float* ln_g = c.in[29]; const float* ln_b = c.in[30]; const float* w_s = c.in[31]; const float* b_s = c.in[32];
    LAS float* Wm = (LAS float*)c.lds;
    LAS float* Vn = (LAS float*)(c.lds + 128 * SP_PITCH * 4);
    LAS float* st = (LAS float*)(c.lds + 2 * 128 * SP_PITCH * 4);
    const int tid = c.tid, lane = c.lane, wv = c.wave, fr = lane & 15, fq = lane >> 4;
    int curg = -1;
    f32x4 pvt[8]; f32x4 lng[8], lnb[8];
    LAS float* st2 = st;
#define SP_DECODE(u_, b_, ch_, g_, dq_) const int g_ = (u_) & 3, b_ = (u_) >> 8, ch_ = ((u_) >> 4) & 15, dq_ = ((u_) >> 2) & 3
#define SP_FETCH(u_, sb_) do { SP_DECODE(u_, fb, fch, fg, fdq); const int fR0 = fb * SEQ + fch * 128, fcb = fg * 512 + fdq * 128; \
        _Pragma("unroll") for (int i = 0; i < 8; ++i) { const int idx = tid + i * 512, j = idx >> 5, d4 = (idx & 31) * 4; pvt[i] = EpiRes::cvt4(*(const u32x2*)(VPRE + (size_t)(fR0 + j) * SGW + fcb + d4)); \
            lng[i] = *(const f32x4*)(ln_g + fcb + d4); lnb[i] = *(const f32x4*)(ln_b + fcb + d4); } \
        if (tid < 128) { const float* lp = LNP + (size_t)(fR0 + tid) * 64; float s1 = 0.f, s2 = 0.f; \
            _Pragma("unroll") for (int i = 0; i < 16; ++i) { const f32x4 t = *(const f32x4*)(lp + i * 4); s1 += t[0] + t[2]; s2 += t[1] + t[3]; } \
            const float mean = s1 * (1.0f / 2048.0f), var = fmaxf(s2 * (1.0f / 2048.0f) - mean * mean, 0.f); \
            st2[(sb_) * 256 + tid * 2] = mean; st2[(sb_) * 256 + tid * 2 + 1] = rsqrtf(var + LN_EPS); } } while (0)
#define SP_STORE(sb_) do { _Pragma("unroll") for (int i = 0; i < 8; ++i) { const int idx = tid + i * 512, j = idx >> 5, d4 = (idx & 31) * 4; \
            const float mean = st2[(sb_) * 256 + j * 2], rstd = st2[(sb_) * 256 + j * 2 + 1]; \
            *(LAS f32x4*)(Vn + j * SP_PITCH + d4) = (pvt[i] - mean) * rstd * lng[i] + lnb[i]; } } while (0)
    int it = 0;
    if (c.bid < 2048) { SP_FETCH(c.bid, 0); }
    for (int unit = c.bid; unit < 2048; unit += c.G, ++it) {
        SP_DECODE(unit, b, ch, g, dq);
        const int R0 = b * SEQ + ch * 128, cb = g * 512 + dq * 128;
        if (g != curg) {
            curg = g;
#pragma unroll
            for (int i = 0; i < 8; ++i) {
                const int idx = tid + i * 512, ii = idx >> 5, j4 = (idx & 31) * 4;
                f32x4 v = *(const f32x4*)(w_s + ((size_t)g * 128 + ii) * 128 + j4);
#pragma unroll
                for (int e = 0; e < 4; ++e) if (j4 + e > ii) v[e] = 0.f;
                *(LAS f32x4*)(Wm + ii * SP_PITCH + j4) = v;
            }
        }
        LDS_BARRIER();
        SP_STORE(it & 1);
        LDS_BARRIER();
        if (unit + c.G < 2048) SP_FETCH(unit + c.G, (it + 1) & 1);
        {
            const int p = wv & 3, dh = wv >> 2;
#pragma unroll
            for (int half = 0; half < 2; ++half) {
                const int ib = half ? 7 - p : p;
                f32x4 acc[4];
#pragma unroll
                for (int nf = 0; nf < 4; ++nf) acc[nf] = (f32x4){0.f, 0.f, 0.f, 0.f};
                const int ii = ib * 16 + fr, R = R0 + ii; const float bs = b_s[g * 128 + ii];
                u32x2 ur[4];
#pragma unroll
                for (int nf = 0; nf < 4; ++nf) ur[nf] = *(const u32x2*)(U2 + (size_t)R * SGW + cb + dh * 64 + nf * 16 + fq * 4);
                for (int j0 = 0; j0 < (ib + 1) * 16; j0 += 4) {
                    const float bw = Wm[(ib * 16 + fr) * SP_PITCH + j0 + fq];
#pragma unroll
                    for (int nf = 0; nf < 4; ++nf) {
                        const float av = Vn[(j0 + fq) * SP_PITCH + dh * 64 + nf * 16 + fr];
                        acc[nf] = __builtin_amdgcn_mfma_f32_16x16x4f32(av, bw, acc[nf], 0, 0, 0);
                    }
                }
#pragma unroll
                for (int nf = 0; nf < 4; ++nf) {
                    const int col = cb + dh * 64 + nf * 16 + fq * 4;
                    const f32x4 o = acc[nf] + bs;
                    u32x2 pk; pk.x = cvt_pk_bf16(__uint_as_float(ur[nf].x << 16) * o[0], __uint_as_float(ur[nf].x & 0xffff0000u) * o[1]);
                    pk.y = cvt_pk_bf16(__uint_as_float(ur[nf].y << 16) * o[2], __uint_as_float(ur[nf].y & 0xffff0000u) * o[3]);
                    *(u32x2*)(G2 + (size_t)R * SGW + col) = pk;
                }
            }
        }
    }
    LDS_BARRIER();
#undef SP_DECODE
#undef SP_FETCH
#undef SP_STORE
    const int gw = c.bid * 8 + c.wave, nw = c.G * 8;
    for (int r = gw; r < MS; r += nw) {
        const int R = MP + r;
        const float* lp = LNP + (size_t)R * 64;
        const float t = lane < 32 ? lp[lane * 2] : lp[(lane - 32) * 2 + 1];
        float s = t;
#pragma unroll
        for (int o = 16; o >= 1; o >>= 1) s += __shfl_xor(s, o);
        const float s1 = __shfl(s, 0), s2 = __shfl(s, 32);
        const float mean = s1 * (1.0f / 2048.0f), rstd = rsqrtf(fmaxf(s2 * (1.0f / 2048.0f) - mean * mean, 0.f) + LN_EPS);
#pragma unroll
        for (int i = 0; i < 8; ++i) {
            const int col = i * 256 + lane * 4, g = col >> 9;
            const f32x4 vn = (EpiRes::cvt4(*(const u32x2*)(VPRE + (size_t)R * SGW + col)) - mean) * rstd * *(const f32x4*)(ln_g + col) + *(const f32x4*)(ln_b + col);
            *(f32x4*)(c.out + O_SGV + (size_t)r * SGW + col) = vn;
            const f32x4 o = vn * w_s[(size_t)g * 16384] + b_s[g * 128];
            const u32x2 ur = *(const u32x2*)(U2 + (size_t)R * SGW + col);
            u32x2 pk; pk.x = cvt_pk_bf16(__uint_as_float(ur.x << 16) * o[0], __uint_as_float(ur.x & 0xffff0000u) * o[1]);
            pk.y = cvt_pk_bf16(__uint_as_float(ur.y << 16) * o[2], __uint_as_float(ur.y & 0xffff0000u) * o[3]);
            *(u32x2*)(G2 + (size_t)R * SGW + col) = pk;
        }
    }
}

__device__ __forceinline__ void phase_final(const Ctx& c) {
    const bf16_t* XB = WSP(bf16_t, OFF_XB); const float* SSQP = WSP(float, OFF_SSQP); const float* gf = c.in[12];
    const int gw = c.bid * 8 + c.wave, nw = c.G * 8;
    for (int row = gw; row < MR; row += nw) {
        const float rs = rstd_row(SSQP, row);
        float* o = row < MP ? c.out + O_YP + (size_t)row * DM : c.out + O_YS + (size_t)(row - MP) * DM;
        u32x2 xr[4];
#pragma unroll
        for (int i = 0; i < 4; ++i) xr[i] = *(const u32x2*)(XB + (size_t)row * DM + i * 256 + c.lane * 4);
#pragma unroll
        for (int i = 0; i < 4; ++i) { const int col = i * 256 + c.lane * 4;
            const f32x4 xv = (f32x4){__uint_as_float(xr[i].x << 16), __uint_as_float(xr[i].x & 0xffff0000u), __uint_as_float(xr[i].y << 16), __uint_as_float(xr[i].y & 0xffff0000u)};
            *(f32x4*)(o + col) = xv * rs * *(const f32x4*)(gf + col); }
    }
}

constexpr int NPHASE = 20;
#ifndef PHMASK
#define PHMASK 0xFFFFF
#endif
#define ON(k) ((PHMASK >> (k)) & 1)
#ifndef PROBE_AMASK
#define PROBE_AMASK 3
#endif
#ifndef PROBE_REP
#define PROBE_REP -1
#endif
#define REPS(k) for (int rep_ = 0; rep_ < 1 + (PROBE_REP == (k)); ++rep_)
#ifndef PROBE_GDUP
#define PROBE_GDUP -1
#endif
template <class Epi> __device__ __forceinline__ void run_gemm(const Ctx& c, const bf16_t* A, const bf16_t* Bt, int K, int nN, const Epi& E, bool withmem = false, int phid = -2) {
    pg8::Gemm g{A, Bt, MT, nN * 256, K};
    Order2 S; S.init(MP / 256, nN, c.G, c.bid); if (withmem) S.add(MMEM / 256, 16, MT / 256, 9); if (phid == PROBE_GDUP) S.dup = 2;
    if (nN == 4) pg8::gemm_phase<Epi, Order2, false, true>(c.lds, g, S, E);
    else pg8::gemm_phase<Epi, Order2, true, true>(c.lds, g, S, E);
    skinny_gemm(c, A, Bt, K, nN * 256, E);
}

__global__ void __launch_bounds__(512, 2) mega_fwd(Params prm) {
    extern __shared__ __attribute__((aligned(16))) unsigned char lds_raw[];
    cg::grid_group grid = cg::this_grid();
    Ctx c; c.in = prm.in; c.out = prm.out; c.ws = prm.ws; c.tid = threadIdx.x; c.lane = c.tid & 63; c.wave = __builtin_amdgcn_readfirstlane(c.tid >> 6);
    c.G = gridDim.x; c.bid = blockIdx.x; c.lds = (LAS unsigned char*)lds_raw;
    bf16_t* XB = WSP(bf16_t, OFF_XB); float* SSQP = WSP(float, OFF_SSQP);
    volatile LAS unsigned* bst = (volatile LAS unsigned*)(c.lds + LDS_BYTES - 16);
    if (c.tid < 4) bst[c.tid] = 0u;
    __syncthreads();
    const XcdBarrier xbar = xcd_barrier_post((unsigned*)(prm.ws + OFF_BAR), bst);
    const int lo = prm.lo, hi = prm.hi;
#define IN(k) (ON((k) >= 14 && (k) <= 18 ? (k) - 8 : (k)) && lo <= (k) && (k) < hi)
#define SYNC(k) do { if (lo <= (k) && (k) + 1 < hi) xcd_barrier(xbar); } while (0)
    if (lo < 0) grid.sync();
#define XATTN_MLP(l, pb) \
    if (IN(pb)) REPS(pb) { EpiNormBf16<0> E{SSQP, WSP(bf16_t, OFF_Q), DM, QSCALE}; run_gemm(c, XB, WSP(bf16_t, OFF_WQ) + (size_t)(l) * 1048576, 1024, 4, E); } SYNC(pb); \
    if (IN(pb + 1)) REPS(pb + 1) { phase_attn(c, l, rep_ ? PROBE_AMASK : 3); } SYNC(pb + 1); \
    if (IN(pb + 2)) { EpiRes E{false, nullptr, nullptr, XB, SSQP}; run_gemm(c, WSP(bf16_t, OFF_OAT), WSP(bf16_t, OFF_WO) + (size_t)(l) * 1048576, 1024, 4, E); } SYNC(pb + 2); \
    if (IN(pb + 3)) REPS(pb + 3) { EpiNormBf16<1> E{SSQP, WSP(bf16_t, OFF_U), DFF, 1.0f}; run_gemm(c, XB, WSP(bf16_t, OFF_WUP) + (size_t)(l) * 4194304, 1024, 16, E, false, pb + 3); } SYNC(pb + 3); \
    if (IN(pb + 4)) { EpiRes E{false, nullptr, nullptr, XB, SSQP}; run_gemm(c, WSP(bf16_t, OFF_U), WSP(bf16_t, OFF_WDN) + (size_t)(l) * 4194304, 4096, 4, E); } SYNC(pb + 4);
    if (IN(0)) REPS(0) { phase_prologue(c); } SYNC(0);
    if (IN(1)) REPS(1) { EpiInMem E{SSQP, WSP(float, OFF_MSSQ), WSP(bf16_t, OFF_Z), c.out, WSP(bf16_t, OFF_KB), WSP(bf16_t, OFF_VT)}; run_gemm(c, XB, WSP(bf16_t, OFF_WA), 1024, 9, E, true, 1); } SYNC(1);
    if (IN(2)) REPS(2) { phase_pool_prep(c); } SYNC(2);
    if (IN(3)) REPS(3) { phase_scan(c); } SYNC(3);
    if (IN(4)) REPS(4) { phase_post(c); } SYNC(4);
    if (IN(5)) { EpiRes E{true, c.in[0], c.in[1], XB, SSQP}; run_gemm(c, WSP(bf16_t, OFF_CAT), WSP(bf16_t, OFF_WOAB), 1024, 4, E, false, 5); } SYNC(5);
    XATTN_MLP(0, 6)
    if (IN(11)) REPS(11) { EpiGelu E{SSQP, WSP(bf16_t, OFF_U2), WSP(bf16_t, OFF_VPRE), WSP(float, OFF_LNP)}; run_gemm(c, XB, WSP(bf16_t, OFF_WINC), 1024, 16, E, false, 11); } SYNC(11);
    if (IN(12)) REPS(12) { phase_spatial(c); } SYNC(12);
    if (IN(13)) { EpiRes E{false, nullptr, nullptr, XB, SSQP}; run_gemm(c, WSP(bf16_t, OFF_G2), WSP(bf16_t, OFF_WOUTC), 2048, 4, E); } SYNC(13);
    XATTN_MLP(1, 14)
    if (IN(19)) { phase_final(c); }
#undef IN
#undef SYNC
}

#ifndef MK_MULTI
#define MK_MULTI 0
#endif
extern "C" void kernel_launch(void* const* d_in, const int* in_sizes, int n_in, void* d_out, int out_size, void* d_ws, size_t ws_size, hipStream_t stream) {
    static int grid = 0;
    if (grid == 0) {
        int dev = 0, cus = 0, per_cu = 0;
        if (n_in != 40 || ws_size < OFF_END) { fprintf(stderr, "kernel_launch: unexpected n_in %d / ws_size %zu (need %zu)\n", n_in, ws_size, (size_t)OFF_END); grid = -1; return; }
        (void)hipGetDevice(&dev); (void)hipDeviceGetAttribute(&cus, hipDeviceAttributeMultiprocessorCount, dev);
        if (hipFuncSetAttribute((const void*)mega_fwd, hipFuncAttributeMaxDynamicSharedMemorySize, LDS_BYTES) != hipSuccess) { fprintf(stderr, "kernel_launch: hipFuncSetAttribute failed\n"); grid = -1; return; }
        if (hipOccupancyMaxActiveBlocksPerMultiprocessor(&per_cu, (const void*)mega_fwd, 512, LDS_BYTES) != hipSuccess || per_cu < 1) { fprintf(stderr, "kernel_launch: occupancy query says %d blocks per CU\n", per_cu); grid = -1; (void)hipGetLastError(); return; }
        grid = cus;
    }
    if (grid < 0) return;
    if (hipMemsetAsync((char*)d_ws + OFF_BAR, 0, XCD_BAR_WORDS * 4, stream) != hipSuccess) { fprintf(stderr, "kernel_launch: memset failed\n"); return; }
    Params p{};
    for (int i = 0; i < 40; ++i) p.in[i] = (const float*)d_in[i];
    p.out = (float*)d_out; p.ws = (unsigned char*)d_ws;
#if MK_MULTI
    for (int ph = 0; ph < NPHASE; ++ph) { p.lo = ph; p.hi = ph + 1; hipLaunchKernelGGL(mega_fwd, dim3(grid), dim3(512), LDS_BYTES, stream, p); }
#else
    p.lo = 0; p.hi = NPHASE;
    void* args[] = {&p};
    hipError_t e = hipLaunchCooperativeKernel((const void*)mega_fwd, dim3(grid), dim3(512), args, LDS_BYTES, stream);
    if (e != hipSuccess) fprintf(stderr, "cooperative launch failed: %s (grid %d)\n", hipGetErrorString(e), grid);
#endif
}
```

```cpp
#include <hip/hip_runtime.h>
#include <hip/hip_cooperative_groups.h>
#include <cstdio>
#include <cstdint>
namespace cg = cooperative_groups;
namespace pg8 {
#define PG8_LAS __attribute__((address_space(3)))
typedef unsigned short bf16_t;
typedef short bf16x8 __attribute__((ext_vector_type(8)));
typedef float f32x4 __attribute__((ext_vector_type(4)));
typedef unsigned u32x4 __attribute__((ext_vector_type(4)));
constexpr int BM = 256, BK = 64, HALF = 128, HTB = HALF * BK * 2  , STAGE_BYTES = 8 * HTB, NXCD = 8, WGM = 8;

__host__ __device__ __forceinline__ int lds_byte(int r, int c) { const int st = (r >> 4) * 2 + (c >> 5), rr = r & 15, cc = c & 31, ob = rr * 64 + cc * 2; return st * 1024 + (ob ^ (((ob >> 9) & 1) << 5)); }
__host__ __device__ __forceinline__ void stage_rc(int b, int& R, int& C) { const int st = b / 1024, sb = b % 1024, swz = sb ^ (((sb >> 9) & 1) << 5); R = (st >> 1) * 16 + swz / 64; C = (st & 1) * 32 + (swz % 64) / 2; }
__host__ __device__ __forceinline__ int perm32(int rho) { const int n = rho >> 4, i = rho & 15; return 8 * (i >> 2) + 4 * n + (i & 3); }

struct Unit { int pm, pn; };
struct Gemm { const bf16_t* A; const bf16_t* Bt; int M, N, K; };

struct StaticOrder {
    int nM, nN, nwg, G, c;
    __host__ __device__ void init(int M, int N, int G_, int c_) { nM = M / BM; nN = N / BM; nwg = nM * nN; G = G_; c = c_; }
    __host__ __device__ bool next(int i, Unit& u) const {
        const long L = (long)i * G + c; if (L >= nwg) return false;
        int wgid = (int)L; { const int q = nwg / NXCD, r = nwg % NXCD, xcd = wgid % NXCD, off = wgid / NXCD; wgid = (xcd < r ? xcd * (q + 1) : r * (q + 1) + (xcd - r) * q) + off; }
        const int nig = WGM * nN, gid = wgid / nig, fm = gid * WGM, gsz = (nM - fm) < WGM ? (nM - fm) : WGM;
        u.pm = fm + ((wgid % nig) % gsz); u.pn = (wgid % nig) / gsz; return true;
    }
    __device__ __forceinline__ void a_ready(const Unit&) const {}
    __device__ __forceinline__ void done(const Unit&) const {}
};

__device__ __forceinline__ unsigned cvt_pk_bf16(float lo, float hi) { unsigned r; asm volatile("v_cvt_pk_bf16_f32 %0, %1, %2" : "=v"(r) : "v"(lo), "v"(hi)); return r; }
typedef float f32x2 __attribute__((ext_vector_type(2)));
__device__ __forceinline__ f32x2 gelu_pk(f32x2 v) {
    const f32x2 av = __builtin_elementwise_abs(v), d = av * 0.2316418882f + 1.0f;
    f32x2 t; t.x = __builtin_amdgcn_rcpf(d.x); t.y = __builtin_amdgcn_rcpf(d.y);
    f32x2 q = t * 0.5307027145f + (-0.7265760135f); q = q * t + 0.7107068705f; q = q * t + (-0.142248368f); q = q * t + 0.127414796f; q = q * t;
    const f32x2 s = (v * v) * (-0.72134752044f);
    f32x2 e; e.x = __builtin_amdgcn_exp2f(s.x); e.y = __builtin_amdgcn_exp2f(s.y);
    const f32x2 m = v * (q * e), r = v - m;
    f32x2 o; o.x = v.x < 0.f ? m.x : r.x; o.y = v.y < 0.f ? m.y : r.y; return o;
}
template <class Epi, class Sched, bool ALIGN_EPI = false, bool SP2 = false>
__device__ __forceinline__ void gemm_phase(PG8_LAS unsigned char* lds, const Gemm g, const Sched& S, const Epi& E) {
    const int tid = threadIdx.x, wid = __builtin_amdgcn_readfirstlane(tid >> 6), lane = tid & 63, wr = wid >> 2, wc = wid & 3, fr = lane & 15, fq = lane >> 4;
    const int K = g.K, nt = K / BK;
    unsigned voffA[2], voffB[2];
#pragma unroll
    for (int i = 0; i < 2; ++i) { int R, C; stage_rc(tid * 16 + i * 8192, R, C); const int Rb = Epi::PERM ? ((R & ~31) + perm32(R & 31)) : R;
        voffA[i] = (unsigned)(R * K + C) * 2u; voffB[i] = (unsigned)(Rb * K + C) * 2u; }
    const size_t kstep = (size_t)(BK * 2);
    const size_t hstep = (size_t)HALF * K * 2;
    const size_t tstep = 2 * hstep;
    const unsigned ldsw = (unsigned)wid * 1024u;
    const int aoff = lds_byte(wr * 64 + fr, fq * 8), boff = lds_byte(wc * 32 + fr, fq * 8);
#define PG8_SA(b, h) (((b) * 2 + (h)) * HTB)
#define PG8_SB(b, h) ((4 + (b) * 2 + (h)) * HTB)
#define PG8_STAGE(bufoff, gbase, voff) do { _Pragma("unroll") for (int _i = 0; _i < 2; ++_i) \
        __builtin_amdgcn_global_load_lds((const unsigned*)((const char*)(gbase) + (voff)[_i]), (PG8_LAS unsigned*)(lds + (bufoff) + ldsw + _i * 8192), 16, 0, 0); } while (0)
#define PG8_LDA(dst, b, h) do { _Pragma("unroll") for (int m = 0; m < 4; ++m) _Pragma("unroll") for (int k = 0; k < 2; ++k) dst[m][k] = *(const PG8_LAS bf16x8*)(lds + PG8_SA(b, h) + aoff + m * 2048 + k * 1024); } while (0)
#define PG8_LDB(dst, b, h) do { _Pragma("unroll") for (int n = 0; n < 2; ++n) _Pragma("unroll") for (int k = 0; k < 2; ++k) dst[n][k] = *(const PG8_LAS bf16x8*)(lds + PG8_SB(b, h) + boff + n * 2048 + k * 1024); } while (0)
#define PG8_MMA(ai, bj, At, Bt) do { __builtin_amdgcn_s_setprio(1); _Pragma("unroll") for (int m = 0; m < 4; ++m) _Pragma("unroll") for (int n = 0; n < 2; ++n) _Pragma("unroll") for (int k = 0; k < 2; ++k) \
        acc[ai][bj][m][n] = __builtin_amdgcn_mfma_f32_16x16x32_bf16(Bt[n][k], At[m][k], acc[ai][bj][m][n], 0, 0, 0); __builtin_amdgcn_s_setprio(0); } while (0)
#define PG8_WAIT_V(n) asm volatile("s_waitcnt vmcnt(" #n ")" ::: "memory")
#define PG8_WAIT_L(n) asm volatile("s_waitcnt lgkmcnt(" #n ")" ::: "memory")
#define PG8_BAR __builtin_amdgcn_s_barrier()
#define PG8_SCHED __builtin_amdgcn_sched_barrier(0)
    Unit cur, nxt; int ui = 0;
    if (!S.next(0, cur)) return;
    f32x4 acc[2][2][4][2];
#pragma unroll
    for (int a = 0; a < 2; ++a)
#pragma unroll
        for (int b = 0; b < 2; ++b)
#pragma unroll
            for (int m = 0; m < 4; ++m)
#pragma unroll
                for (int n = 0; n < 2; ++n) acc[a][b][m][n] = (f32x4){0.f, 0.f, 0.f, 0.f};
    bf16x8 At[4][2], B0[2][2], B1[2][2];
    const char* cA = (const char*)g.A + (size_t)cur.pm * tstep; const char* cB = (const char*)g.Bt + (size_t)cur.pn * tstep;
    S.a_ready(cur);
    if constexpr (SP2) {
        PG8_STAGE(PG8_SB(0, 0), cB, voffB); PG8_STAGE(PG8_SB(0, 1), cB + hstep, voffB); PG8_STAGE(PG8_SA(0, 0), cA, voffA); PG8_STAGE(PG8_SA(0, 1), cA + hstep, voffA);
        if (wr == 1) PG8_BAR;
        PG8_WAIT_V(2); PG8_BAR;
        PG8_STAGE(PG8_SB(1, 0), cB + kstep, voffB); PG8_STAGE(PG8_SA(1, 0), cA + kstep, voffA); PG8_STAGE(PG8_SB(1, 1), cB + hstep + kstep, voffB);
        PG8_WAIT_V(6); PG8_BAR;
    } else {
        PG8_STAGE(PG8_SB(0, 0), cB, voffB); PG8_STAGE(PG8_SA(0, 0), cA, voffA); PG8_STAGE(PG8_SB(0, 1), cB + hstep, voffB); PG8_STAGE(PG8_SA(0, 1), cA + hstep, voffA);
        if (wr == 1) PG8_BAR;
        PG8_WAIT_V(4); PG8_BAR;
        PG8_STAGE(PG8_SB(1, 0), cB + kstep, voffB); PG8_STAGE(PG8_SA(1, 0), cA + kstep, voffA); PG8_STAGE(PG8_SB(1, 1), cB + hstep + kstep, voffB);
        PG8_WAIT_V(6); PG8_BAR;
    }
    for (;;) {
        const bool has_next = S.next(ui + 1, nxt);
        const char* nA = has_next ? (const char*)g.A + (size_t)nxt.pm * tstep : cA; const char* nB = has_next ? (const char*)g.Bt + (size_t)nxt.pn * tstep : cB;
        for (int t = 0; t < nt; t += 2) {
            const bool last = (t == nt - 2);
            const char* a1 = cA + (size_t)(t + 1) * kstep;
            const char* a2 = last ? nA : cA + (size_t)(t + 2) * kstep; const char* b2 = last ? nB : cB + (size_t)(t + 2) * kstep;
            const char* a3 = a2 + kstep; const char* b3 = b2 + kstep;
            if (last && has_next) S.a_ready(nxt);
            if constexpr (SP2) {
            PG8_LDB(B0, 0, 0); PG8_LDB(B1, 0, 1); PG8_SCHED; PG8_LDA(At, 0, 0); PG8_STAGE(PG8_SA(1, 1), a1 + hstep, voffA);
            PG8_WAIT_V(8); PG8_WAIT_L(0); PG8_BAR; PG8_MMA(0, 0, At, B0); PG8_MMA(0, 1, At, B1); PG8_BAR; PG8_SCHED;
            PG8_LDA(At, 0, 1); PG8_STAGE(PG8_SB(0, 0), b2, voffB); PG8_STAGE(PG8_SB(0, 1), b2 + hstep, voffB); PG8_STAGE(PG8_SA(0, 0), a2, voffA);
            PG8_WAIT_V(8); PG8_WAIT_L(0); PG8_BAR; PG8_MMA(1, 0, At, B0); PG8_MMA(1, 1, At, B1); PG8_BAR; PG8_SCHED;
            PG8_LDB(B0, 1, 0); PG8_LDB(B1, 1, 1); PG8_SCHED; PG8_LDA(At, 1, 0); PG8_STAGE(PG8_SA(0, 1), a2 + hstep, voffA);
            PG8_WAIT_V(8); PG8_WAIT_L(0); PG8_BAR; PG8_MMA(0, 0, At, B0); PG8_MMA(0, 1, At, B1); PG8_BAR; PG8_SCHED;
            PG8_LDA(At, 1, 1); PG8_STAGE(PG8_SB(1, 0), b3, voffB); PG8_STAGE(PG8_SB(1, 1), b3 + hstep, voffB); PG8_STAGE(PG8_SA(1, 0), a3, voffA);
            PG8_WAIT_V(8); PG8_WAIT_L(0); PG8_BAR; PG8_MMA(1, 0, At, B0); PG8_MMA(1, 1, At, B1); PG8_BAR; PG8_SCHED;
            } else {
            PG8_LDB(B0, 0, 0); PG8_SCHED; PG8_LDA(At, 0, 0); PG8_STAGE(PG8_SA(1, 1), a1 + hstep, voffA);
            PG8_WAIT_L(8); PG8_BAR; PG8_WAIT_L(0); PG8_MMA(0, 0, At, B0); PG8_BAR; PG8_SCHED;
            PG8_LDB(B1, 0, 1); PG8_STAGE(PG8_SB(0, 0), b2, voffB);
            PG8_BAR; PG8_WAIT_L(0); PG8_MMA(0, 1, At, B1); PG8_BAR;
            PG8_LDA(At, 0, 1); PG8_STAGE(PG8_SA(0, 0), a2, voffA);
            PG8_BAR; PG8_WAIT_L(0); PG8_MMA(1, 0, At, B0); PG8_BAR; PG8_SCHED;
            PG8_STAGE(PG8_SB(0, 1), b2 + hstep, voffB);
            PG8_WAIT_V(6); PG8_BAR; PG8_MMA(1, 1, At, B1); PG8_BAR;
            PG8_LDB(B0, 1, 0); PG8_SCHED; PG8_LDA(At, 1, 0); PG8_STAGE(PG8_SA(0, 1), a2 + hstep, voffA);
            PG8_WAIT_L(8); PG8_BAR; PG8_WAIT_L(0); PG8_MMA(0, 0, At, B0); PG8_BAR; PG8_SCHED;
            PG8_LDB(B1, 1, 1); PG8_STAGE(PG8_SB(1, 0), b3, voffB);
            PG8_BAR; PG8_WAIT_L(0); PG8_MMA(0, 1, At, B1); PG8_BAR;
            PG8_LDA(At, 1, 1); PG8_STAGE(PG8_SA(1, 0), a3, voffA);
            PG8_BAR; PG8_WAIT_L(0); PG8_MMA(1, 0, At, B0); PG8_BAR; PG8_SCHED;
            PG8_STAGE(PG8_SB(1, 1), b3 + hstep, voffB);
            PG8_WAIT_V(6); PG8_BAR; PG8_MMA(1, 1, At, B1); PG8_BAR;
            }
        }
        if constexpr (ALIGN_EPI) { if (wr == 0) PG8_BAR; }
        if constexpr (!Epi::AFTER_DRAIN) { E(acc, cur, wr, wc, fr, fq); S.done(cur); }
        if (!has_next) break;
#pragma unroll
        for (int a = 0; a < 2; ++a)
#pragma unroll
            for (int b = 0; b < 2; ++b)
#pragma unroll
                for (int m = 0; m < 4; ++m)
#pragma unroll
                    for (int n = 0; n < 2; ++n) acc[a][b][m][n] = (f32x4){0.f, 0.f, 0.f, 0.f};
        cur = nxt; cA = nA; cB = nB; ++ui;
        if constexpr (ALIGN_EPI) { if (wr == 1) PG8_BAR; }
    }
    PG8_WAIT_V(0);
    if constexpr (!ALIGN_EPI) { if (wr == 0) PG8_BAR; }
    PG8_BAR;
    if constexpr (Epi::AFTER_DRAIN) { E.fused(acc, cur, wr, wc, fr, fq, lds, wid, lane); S.done(cur); }
#undef PG8_SA
#undef PG8_SB
#undef PG8_STAGE
#undef PG8_LDA
#undef PG8_LDB
#undef PG8_MMA
#undef PG8_WAIT_V
#undef PG8_WAIT_L
#undef PG8_BAR
#undef PG8_SCHED
}
}

using pg8::bf16_t; using pg8::bf16x8; using pg8::f32x4; using pg8::u32x4; using pg8::f32x2; using pg8::Unit; using pg8::cvt_pk_bf16;
#define LAS __attribute__((address_space(3)))
typedef short bf16x4 __attribute__((ext_vector_type(4)));
typedef unsigned u32x2 __attribute__((ext_vector_type(2)));

constexpr int DM = 1024, SEQ = 2048, NBP = 8, MP = 16384, MS = 128, MR = 16512, MT = 16640, MMEM = 2048;
constexpr int ABIN = 2304, RIN = 1792, PW = 512, DFF = 4096, SGW = 2048;
constexpr float RMS_EPS = 1e-5f, LN_EPS = 1e-5f, GN_EPS = 64e-5f;
constexpr float QSCALE = 0.0625f * 1.4426950408889634f;

constexpr size_t O_YP = 0, O_YS = 16777216, O_MK = 16908288, O_MV = 21102592, O_PP = 25296896, O_PS = 25358336, O_SHP = 26341376, O_SHS = 26355712,
                 O_WKP = 26585088, O_WKS = 26847232, O_SGV = 31041536;

constexpr size_t al256(size_t x) { return (x + 255) & ~(size_t)255; }
constexpr size_t OFF_WA = 0;
constexpr size_t OFF_WOAB = OFF_WA + (size_t)6400 * 1024 * 2;
constexpr size_t OFF_WQ = OFF_WOAB + (size_t)1024 * 1024 * 2;
constexpr size_t OFF_WO = OFF_WQ + (size_t)2 * 1024 * 1024 * 2;
constexpr size_t OFF_WUP = OFF_WO + (size_t)2 * 1024 * 1024 * 2;
constexpr size_t OFF_WDN = OFF_WUP + (size_t)2 * 4096 * 1024 * 2;
constexpr size_t OFF_WINC = OFF_WDN + (size_t)2 * 4096 * 1024 * 2;
constexpr size_t OFF_WOUTC = OFF_WINC + (size_t)4096 * 1024 * 2;
constexpr size_t OFF_POOLWT = OFF_WOUTC + (size_t)2048 * 1024 * 2;
constexpr size_t OFF_W2T = OFF_POOLWT + (size_t)4 * 128 * 128 * 2;
constexpr size_t OFF_A2T = OFF_W2T + (size_t)512 * 64 * 2;
constexpr size_t OFF_G2T = OFF_A2T + (size_t)512 * 64 * 2;
constexpr size_t OFF_XB = OFF_G2T + (size_t)512 * 128 * 2;
constexpr size_t OFF_X = OFF_XB + (size_t)(MT + MMEM) * 1024 * 2;
constexpr size_t OFF_SSQP = OFF_X + (size_t)MT * 1024 * 4;
constexpr size_t OFF_MSSQ = OFF_SSQP + (size_t)MT * 16 * 4;
constexpr size_t OFF_Z = OFF_MSSQ + (size_t)MMEM * 4;
constexpr size_t OFF_SC = OFF_Z + (size_t)MT * ABIN * 4;
constexpr size_t OFF_GATE = OFF_SC + (size_t)MR * 8 * 384 * 4;
constexpr size_t OFF_YR = OFF_GATE + (size_t)MT * 512 * 4;
constexpr size_t OFF_CAT = OFF_YR + (size_t)MT * 512 * 4;
constexpr size_t OFF_Q = OFF_CAT + (size_t)MT * 1024 * 2;
constexpr size_t OFF_OAT = OFF_Q + (size_t)MT * 1024 * 2;
constexpr size_t OFF_KB = OFF_OAT + (size_t)MT * 1024 * 2;
constexpr size_t OFF_VT = OFF_KB + (size_t)2 * 2048 * 1024 * 2;
constexpr size_t OFF_LNP = OFF_VT + (size_t)2 * 2048 * 1024 * 2;
constexpr size_t OFF_BAR = OFF_LNP + (size_t)MT * 64 * 4;
constexpr size_t OFF_END = OFF_BAR + 16384;
constexpr size_t OFF_U = OFF_Z;
constexpr size_t OFF_U2 = OFF_Z;
constexpr size_t OFF_VPRE = OFF_SC;
constexpr size_t OFF_G2 = OFF_GATE;
static_assert((size_t)MT * 4096 * 2 <= (size_t)MT * ABIN * 4 && (size_t)MT * 2048 * 4 <= (size_t)MR * 8 * 384 * 4 && (size_t)MT * 2048 * 2 <= (size_t)2 * MT * 512 * 4, "overlays");
static_assert(OFF_XB % 256 == 0 && OFF_Z % 256 == 0 && OFF_SC % 256 == 0 && OFF_CAT % 256 == 0 && OFF_VT % 256 == 0 && OFF_LNP % 256 == 0, "align");

constexpr int LDS_BYTES = 139264;

struct Params { const float* in[40]; float* out; unsigned char* ws; int lo, hi; };

struct Ctx {
    const float* const* in; float* out; unsigned char* ws;
    int tid, lane, wave, G, bid;
    LAS unsigned char* lds;
};
#define WSP(T, off) ((T*)(c.ws + (off)))
#define LDS_BARRIER() do { asm volatile("s_waitcnt lgkmcnt(0)" ::: "memory"); __builtin_amdgcn_s_barrier(); asm volatile("" ::: "memory"); } while (0)

__device__ __forceinline__ float wave_sum(float v) {
#pragma unroll
    for (int o = 32; o >= 1; o >>= 1) v += __shfl_xor(v, o);
    return v;
}
__device__ __forceinline__ float wave_max(float v) {
#pragma unroll
    for (int o = 32; o >= 1; o >>= 1) v = fmaxf(v, __shfl_xor(v, o));
    return v;
}
__device__ __forceinline__ float bf2f(unsigned short b) { return __uint_as_float(((unsigned)b) << 16); }
__device__ __forceinline__ float sigmoidf_(float x) { return __builtin_amdgcn_rcpf(1.0f + __expf(-x)); }
__device__ __forceinline__ float tanhf_(float x) { return 1.0f - 2.0f * __builtin_amdgcn_rcpf(__expf(2.0f * x) + 1.0f); }
__device__ __forceinline__ const float* x0_row(const Ctx& c, int row) {
    return row < MP ? c.in[0] + (size_t)row * DM : c.in[1] + (size_t)((row - MP) & 127) * DM;
}
__device__ __forceinline__ float rstd_row(const float* SSQP, int row) {
    const f32x4* p = (const f32x4*)(SSQP + (size_t)row * 16);
    const f32x4 a = p[0], b = p[1], cc = p[2], d = p[3];
    const float s = ((a[0] + a[1]) + (a[2] + a[3])) + ((b[0] + b[1]) + (b[2] + b[3])) + ((cc[0] + cc[1]) + (cc[2] + cc[3])) + ((d[0] + d[1]) + (d[2] + d[3]));
    return rsqrtf(s * (1.0f / 1024.0f) + RMS_EPS);
}

struct TJob { const float* W; const float* g; bf16_t* dst; int K, N; };
constexpr int NJOBS = 23;
__device__ __forceinline__ TJob get_job(const Ctx& c, int j) {
    TJob t; t.g = nullptr;
    if (j == 0) { t.W = c.in[13]; t.g = c.in[8]; t.dst = WSP(bf16_t, OFF_WA); t.K = 1024; t.N = 2304; }
    else if (j <= 4) { const int i = j - 1, l = i >> 1, v = i & 1; t.W = c.in[v ? 36 : 35] + (size_t)l * 1048576; t.g = c.in[10] + l * 1024;
        t.dst = WSP(bf16_t, OFF_WA) + (size_t)(2304 + i * 1024) * 1024; t.K = 1024; t.N = 1024; }
    else if (j == 5) { t.W = c.in[14]; t.dst = WSP(bf16_t, OFF_WOAB); t.K = 1024; t.N = 1024; }
    else if (j <= 7) { const int l = j - 6; t.W = c.in[34] + (size_t)l * 1048576; t.g = c.in[9] + l * 1024; t.dst = WSP(bf16_t, OFF_WQ) + (size_t)l * 1048576; t.K = 1024; t.N = 1024; }
    else if (j <= 9) { const int l = j - 8; t.W = c.in[37] + (size_t)l * 1048576; t.dst = WSP(bf16_t, OFF_WO) + (size_t)l * 1048576; t.K = 1024; t.N = 1024; }
    else if (j <= 11) { const int l = j - 10; t.W = c.in[38] + (size_t)l * 4194304; t.g = c.in[11] + l * 1024; t.dst = WSP(bf16_t, OFF_WUP) + (size_t)l * 4194304; t.K = 1024; t.N = 4096; }
    else if (j <= 13) { const int l = j - 12; t.W = c.in[39] + (size_t)l * 4194304; t.dst = WSP(bf16_t, OFF_WDN) + (size_t)l * 4194304; t.K = 4096; t.N = 1024; }
    else if (j == 14) { t.W = c.in[28]; t.g = c.in[8] + 1024; t.dst = WSP(bf16_t, OFF_WINC); t.K = 1024; t.N = 4096; }
    else if (j == 15) { t.W = c.in[33]; t.dst = WSP(bf16_t, OFF_WOUTC); t.K = 2048; t.N = 1024; }
    else if (j <= 19) { const int g = j - 16; t.W = c.in[15] + g * 16384; t.dst = WSP(bf16_t, OFF_POOLWT) + g * 16384; t.K = 128; t.N = 128; }
    else if (j == 20) { t.W = c.in[19]; t.dst = WSP(bf16_t, OFF_W2T); t.K = 64; t.N = 512; }
    else if (j == 21) { t.W = c.in[21]; t.dst = WSP(bf16_t, OFF_A2T); t.K = 64; t.N = 512; }
    else { t.W = c.in[22]; t.dst = WSP(bf16_t, OFF_G2T); t.K = 128; t.N = 512; }
    return t;
}

__device__ __forceinline__ void phase_prologue(const Ctx& c) {
    LAS float* tile = (LAS float*)c.lds;
    {
        int off = 0;
#pragma unroll 1
        for (int j = 0; j < NJOBS; ++j) {
            const TJob t = get_job(c, j);
            const int ntn = t.N >> 6, nt = (t.K >> 6) * ntn;
            int first = c.bid - off; if (first < 0) first += c.G;
            off = (off + nt) % c.G;
            f32x4 pv[2]; float pg[2];
#define PRO_LOAD(ti_) do { const int k0_ = ((ti_) / ntn) * 64, n0_ = ((ti_) % ntn) * 64; _Pragma("unroll") for (int i = 0; i < 2; ++i) { const int kk = (c.tid >> 4) + i * 32, nn = (c.tid & 15) * 4; \
                pv[i] = *(const f32x4*)(t.W + (size_t)(k0_ + kk) * t.N + n0_ + nn); pg[i] = t.g ? t.g[k0_ + kk] : 1.0f; } } while (0)
            if (first < nt) PRO_LOAD(first);
            for (int ti = first; ti < nt; ti += c.G) {
                const int k0 = (ti / ntn) * 64, n0 = (ti % ntn) * 64;
#pragma unroll
                for (int i = 0; i < 2; ++i) {
                    const int kk = (c.tid >> 4) + i * 32, nn = (c.tid & 15) * 4;
                    tile[kk * 65 + nn + 0] = pv[i][0] * pg[i]; tile[kk * 65 + nn + 1] = pv[i][1] * pg[i]; tile[kk * 65 + nn + 2] = pv[i][2] * pg[i]; tile[kk * 65 + nn + 3] = pv[i][3] * pg[i];
                }
                LDS_BARRIER();
                if (ti + c.G < nt) PRO_LOAD(ti + c.G);
                {
                    const int n = c.tid >> 3, kq = (c.tid & 7) * 8;
                    u32x4 w;
                    w.x = cvt_pk_bf16(tile[(kq + 0) * 65 + n], tile[(kq + 1) * 65 + n]); w.y = cvt_pk_bf16(tile[(kq + 2) * 65 + n], tile[(kq + 3) * 65 + n]);
                    w.z = cvt_pk_bf16(tile[(kq + 4) * 65 + n], tile[(kq + 5) * 65 + n]); w.w = cvt_pk_bf16(tile[(kq + 6) * 65 + n], tile[(kq + 7) * 65 + n]);
                    *(u32x4*)(t.dst + (size_t)(n0 + n) * t.K + k0 + kq) = w;
                }
                LDS_BARRIER();
            }
#undef PRO_LOAD
        }
    }
    for (int i = c.bid * 512 + c.tid; i < MS * 14 * (PW / 4); i += c.G * 512) {
        const int b = i / (14 * (PW / 4)), r = i % (14 * (PW / 4));
        *(f32x4*)(c.out + O_PS + (size_t)b * 15 * PW + (size_t)r * 4) = *(const f32x4*)(c.in[5] + (size_t)b * 15 * PW + PW + (size_t)r * 4);
    }
    bf16_t* XB = WSP(bf16_t, OFF_XB); float* SSQP = WSP(float, OFF_SSQP); float* MSSQ = WSP(float, OFF_MSSQ);
    const int gw = c.bid * 8 + c.wave, nw = c.G * 8;
    for (int row = gw; row < MT + MMEM; row += nw) {
        const float* src = row < MT ? x0_row(c, row) : c.in[2] + (size_t)(row - MT) * DM;
        float ss = 0.f;
#pragma unroll
        for (int i = 0; i < 4; ++i) {
            const int col = i * 256 + c.lane * 4;
            const f32x4 v = *(const f32x4*)(src + col);
            ss += v[0] * v[0] + v[1] * v[1] + v[2] * v[2] + v[3] * v[3];
            u32x2 w; w.x = cvt_pk_bf16(v[0], v[1]); w.y = cvt_pk_bf16(v[2], v[3]);
            *(u32x2*)(XB + (size_t)row * DM + col) = w;
        }
        ss = wave_sum(ss);
        if (row < MT) { if (c.lane < 16) SSQP[(size_t)row * 16 + c.lane] = c.lane == 0 ? ss : 0.f; }
        else if (c.lane == 0) MSSQ[row - MT] = ss;
    }
}

struct Order2 {
    int nM0, nN0, n0, nM1, nN1, n1, pmo, pno, G, c, dup = 1;
    __device__ __forceinline__ void init(int nM0_, int nN0_, int G_, int c_) { nM0 = nM0_; nN0 = nN0_; n0 = nM0 * nN0; nM1 = 0; nN1 = 1; n1 = 0; pmo = 0; pno = 0; G = G_; c = c_; }
    __device__ __forceinline__ void add(int nM1_, int nN1_, int pmo_, int pno_) { nM1 = nM1_; nN1 = nN1_; n1 = nM1 * nN1; pmo = pmo_; pno = pno_; }
    __device__ __forceinline__ static void map(int w, int nM, int nN, Unit& u) {
        const int nig = pg8::WGM * nN, gid = w / nig, fm = gid * pg8::WGM, gsz = (nM - fm) < pg8::WGM ? (nM - fm) : pg8::WGM;
        u.pm = fm + ((w % nig) % gsz); u.pn = (w % nig) / gsz;
    }
    __device__ __forceinline__ bool next(int i, Unit& u) const {
        const long L = (long)(i / dup) * G + c; const int nwg = n0 + n1; if (L >= nwg) return false;
        int w = (int)L; { const int q = nwg / 8, r = nwg % 8, xcd = w % 8, off = w / 8; w = (xcd < r ? xcd * (q + 1) : r * (q + 1) + (xcd - r) * q) + off; }
        if (w < n0) map(w, nM0, nN0, u); else { map(w - n0, nM1, nN1, u); u.pm += pmo; u.pn += pno; }
        return true;
    }
    __device__ __forceinline__ void a_ready(const Unit&) const {}
    __device__ __forceinline__ void done(const Unit&) const {}
};

#ifndef WT_STORES
#define WT_STORES 0
#endif
__device__ __forceinline__ void st16(void* p, u32x4 v) {
#if WT_STORES
    asm volatile("global_store_dwordx4 %0, %1, off sc0 sc1" :: "v"(p), "v"(v) : "memory");
#else
    *(u32x4*)p = v;
#endif
}
__device__ __forceinline__ void st16f(float* p, f32x4 v) { st16((void*)p, __builtin_bit_cast(u32x4, v)); }
#define EPI_ARGS const f32x4 (&acc)[2][2][4][2], const Unit& u, int wr, int wc, int fr, int fq
#define EPI_RS8(rs, SSQP_, row0) float rs[2][4]; { f32x4 t_[2][4]; \
    _Pragma("unroll") for (int ai = 0; ai < 2; ++ai) _Pragma("unroll") for (int m = 0; m < 4; ++m) t_[ai][m] = *((const f32x4*)((SSQP_) + (size_t)((row0) + ai * 128 + m * 16) * 16) + fq); \
    _Pragma("unroll") for (int ai = 0; ai < 2; ++ai) _Pragma("unroll") for (int m = 0; m < 4; ++m) { float q_ = (t_[ai][m][0] + t_[ai][m][1]) + (t_[ai][m][2] + t_[ai][m][3]); \
        q_ += __shfl_xor(q_, 16); q_ += __shfl_xor(q_, 32); rs[ai][m] = rsqrtf(q_ * (1.0f / 1024.0f) + RMS_EPS); } }
struct EpiInMem {
    static constexpr bool PERM = true, AFTER_DRAIN = false;
    const float* SSQP; const float* MSSQ; bf16_t* Z; float* out; bf16_t* KB; bf16_t* VT;
    __device__ __forceinline__ float sk_scale(int row) const { return rstd_row(SSQP, row); }
    __device__ __forceinline__ f32x4 sk_pre(int row, int col) const { return (f32x4){0.f, 0.f, 0.f, 0.f}; }
    __device__ __forceinline__ void sk_elem(int row, int col, f32x4 v, f32x4 pre, float rs, float& s1, float& s2) const {
        v = v * rs; { u32x2 w; w.x = cvt_pk_bf16(v[0], v[1]); w.y = cvt_pk_bf16(v[2], v[3]); *(u32x2*)(Z + (size_t)row * ABIN + col) = w; }
        if (col >= PW) *(f32x4*)(out + O_SHS + (size_t)(row - MP) * RIN + (col - PW)) = v;
        else *(f32x4*)(out + O_PS + ((size_t)(row - MP) * 15 + 14) * PW + col) = v;
    }
    __device__ __forceinline__ void sk_fin(int row, int slot, float s1, float s2) const {}
    __device__ __forceinline__ void operator()(EPI_ARGS) const {
        if (u.pn < 9) {
            EPI_RS8(rs8, SSQP, u.pm * 256 + wr * 64 + fr);
#pragma unroll
            for (int ai = 0; ai < 2; ++ai)
#pragma unroll
                for (int m = 0; m < 4; ++m) {
                    const int row = u.pm * 256 + ai * 128 + wr * 64 + m * 16 + fr; const float rs = rs8[ai][m];
#pragma unroll
                    for (int bj = 0; bj < 2; ++bj) { const f32x4 v0 = acc[ai][bj][m][0] * rs, v1 = acc[ai][bj][m][1] * rs;
                        u32x4 w; w.x = cvt_pk_bf16(v0[0], v0[1]); w.y = cvt_pk_bf16(v0[2], v0[3]); w.z = cvt_pk_bf16(v1[0], v1[1]); w.w = cvt_pk_bf16(v1[2], v1[3]);
                        st16(Z + (size_t)row * ABIN + u.pn * 256 + bj * 128 + wc * 32 + 8 * fq, w); }
                }
        } else {
            const int j = u.pn - 9, l = j >> 3, isv = (j >> 2) & 1, cb = (j & 3) * 256;
            float* ob = out + (isv ? O_MV : O_MK) + (size_t)l * 2048 * 1024;
#pragma unroll
            for (int ai = 0; ai < 2; ++ai)
#pragma unroll
                for (int m = 0; m < 4; ++m) {
                    const int rm = (u.pm - 65) * 256 + ai * 128 + wr * 64 + m * 16 + fr; const float rs = rsqrtf(MSSQ[rm] * (1.0f / 1024.0f) + RMS_EPS);
#pragma unroll
                    for (int bj = 0; bj < 2; ++bj) {
                        const int col = cb + bj * 128 + wc * 32 + 8 * fq; const f32x4 v0 = acc[ai][bj][m][0] * rs, v1 = acc[ai][bj][m][1] * rs;
                        float* op = ob + (size_t)rm * 1024 + col; *(f32x4*)op = v0; *(f32x4*)(op + 4) = v1;
                        if (!isv) { u32x4 w; w.x = cvt_pk_bf16(v0[0], v0[1]); w.y = cvt_pk_bf16(v0[2], v0[3]); w.z = cvt_pk_bf16(v1[0], v1[1]); w.w = cvt_pk_bf16(v1[2], v1[3]);
                            *(u32x4*)(KB + ((size_t)l * 2048 + rm) * 1024 + col) = w; }
                        else { bf16_t* vp = VT + ((((size_t)l * 8 + (rm >> 8)) * 4 + (col >> 8)) * 256 + (col & 255)) * 256 + (rm & 255);
                            const unsigned a = cvt_pk_bf16(v0[0], v0[1]), b = cvt_pk_bf16(v0[2], v0[3]), cc = cvt_pk_bf16(v1[0], v1[1]), d = cvt_pk_bf16(v1[2], v1[3]);
                            vp[0] = (bf16_t)a; vp[256] = (bf16_t)(a >> 16); vp[512] = (bf16_t)b; vp[768] = (bf16_t)(b >> 16);
                            vp[1024] = (bf16_t)cc; vp[1280] = (bf16_t)(cc >> 16); vp[1536] = (bf16_t)d; vp[1792] = (bf16_t)(d >> 16); }
                    }
                }
        }
    }
};
struct EpiRes {
    static constexpr bool PERM = true, AFTER_DRAIN = false;
    bool first; const float* xp; const float* xs; bf16_t* XB; float* SSQP;
    __device__ __forceinline__ static f32x4 cvt4(u32x2 r) { return (f32x4){__uint_as_float(r.x << 16), __uint_as_float(r.x & 0xffff0000u), __uint_as_float(r.y << 16), __uint_as_float(r.y & 0xffff0000u)}; }
    __device__ __forceinline__ float sk_scale(int row) const { return 1.0f; }
    __device__ __forceinline__ f32x4 sk_pre(int row, int col) const {
        if (first) return *(const f32x4*)(xs + (size_t)(row - MP) * DM + col);
        return cvt4(*(const u32x2*)(XB + (size_t)row * DM + col));
    }
    __device__ __forceinline__ void sk_elem(int row, int col, f32x4 v, f32x4 pre, float rs, float& s1, float& s2) const {
        v += pre;
        u32x2 w; w.x = cvt_pk_bf16(v[0], v[1]); w.y = cvt_pk_bf16(v[2], v[3]); *(u32x2*)(XB + (size_t)row * DM + col) = w;
        s1 += (v[0] * v[0] + v[1] * v[1]) + (v[2] * v[2] + v[3] * v[3]);
    }
    __device__ __forceinline__ void sk_fin(int row, int slot, float s1, float s2) const { SSQP[(size_t)row * 16 + slot] = s1; }
    __device__ __forceinline__ void operator()(EPI_ARGS) const {
#pragma unroll
        for (int ai = 0; ai < 2; ++ai) {
            f32x4 xv[4][2][2];
            if (first) {
#pragma unroll
                for (int m = 0; m < 4; ++m) {
                    const int row = u.pm * 256 + ai * 128 + wr * 64 + m * 16 + fr;
                    const float* xo = xp + (size_t)row * DM;
#pragma unroll
                    for (int bj = 0; bj < 2; ++bj) { const int col = u.pn * 256 + bj * 128 + wc * 32 + 8 * fq; xv[m][bj][0] = *(const f32x4*)(xo + col); xv[m][bj][1] = *(const f32x4*)(xo + col + 4); }
                }
            } else {
                u32x4 xr[4][2];
#pragma unroll
                for (int m = 0; m < 4; ++m) {
                    const int row = u.pm * 256 + ai * 128 + wr * 64 + m * 16 + fr;
#pragma unroll
                    for (int bj = 0; bj < 2; ++bj) xr[m][bj] = *(const u32x4*)(XB + (size_t)row * DM + u.pn * 256 + bj * 128 + wc * 32 + 8 * fq);
                }
#pragma unroll
                for (int m = 0; m < 4; ++m)
#pragma unroll
                    for (int bj = 0; bj < 2; ++bj) { xv[m][bj][0] = cvt4((u32x2){xr[m][bj].x, xr[m][bj].y}); xv[m][bj][1] = cvt4((u32x2){xr[m][bj].z, xr[m][bj].w}); }
            }
            __builtin_amdgcn_sched_barrier(0);
#pragma unroll
            for (int m = 0; m < 4; ++m) {
                const int row = u.pm * 256 + ai * 128 + wr * 64 + m * 16 + fr;
                float ss = 0.f;
#pragma unroll
                for (int bj = 0; bj < 2; ++bj) {
                    const int col = u.pn * 256 + bj * 128 + wc * 32 + 8 * fq;
                    const f32x4 v0 = acc[ai][bj][m][0] + xv[m][bj][0], v1 = acc[ai][bj][m][1] + xv[m][bj][1];
                    u32x4 w; w.x = cvt_pk_bf16(v0[0], v0[1]); w.y = cvt_pk_bf16(v0[2], v0[3]); w.z = cvt_pk_bf16(v1[0], v1[1]); w.w = cvt_pk_bf16(v1[2], v1[3]);
                    st16(XB + (size_t)row * DM + col, w);
                    ss += (v0[0] * v0[0] + v0[1] * v0[1]) + (v0[2] * v0[2] + v0[3] * v0[3]) + (v1[0] * v1[0] + v1[1] * v1[1]) + (v1[2] * v1[2] + v1[3] * v1[3]);
                }
                ss += __shfl_xor(ss, 16); ss += __shfl_xor(ss, 32);
                if (fq == 0) SSQP[(size_t)row * 16 + u.pn * 4 + wc] = ss;
            }
        }
    }
};
template <int MODE> struct EpiNormBf16 {
    static constexpr bool PERM = true, AFTER_DRAIN = false;
    const float* SSQP; bf16_t* O; int ldc; float scale;
    __device__ __forceinline__ float sk_scale(int row) const { return rstd_row(SSQP, row) * scale; }
    __device__ __forceinline__ f32x4 sk_pre(int row, int col) const { return (f32x4){0.f, 0.f, 0.f, 0.f}; }
    __device__ __forceinline__ void sk_elem(int row, int col, f32x4 v, f32x4 pre, float rs, float& s1, float& s2) const {
        v = v * rs;
        if (MODE == 1) {
#pragma unroll
            for (int e = 0; e < 4; ++e) { const float a = fmaxf(v[e], 0.f); v[e] = a * a; }
        }
        u32x2 w; w.x = cvt_pk_bf16(v[0], v[1]); w.y = cvt_pk_bf16(v[2], v[3]); *(u32x2*)(O + (size_t)row * ldc + col) = w;
    }
    __device__ __forceinline__ void sk_fin(int row, int slot, float s1, float s2) const {}
    __device__ __forceinline__ void operator()(EPI_ARGS) const {
        EPI_RS8(rs8, SSQP, u.pm * 256 + wr * 64 + fr);
#pragma unroll
        for (int ai = 0; ai < 2; ++ai)
#pragma unroll
            for (int m = 0; m < 4; ++m) {
                const int row = u.pm * 256 + ai * 128 + wr * 64 + m * 16 + fr; const float rs = rs8[ai][m] * scale;
#pragma unroll
                for (int bj = 0; bj < 2; ++bj) {
                    const int col = u.pn * 256 + bj * 128 + wc * 32 + 8 * fq;
                    f32x4 v0 = acc[ai][bj][m][0] * rs, v1 = acc[ai][bj][m][1] * rs;
                    if (MODE == 1) {
#pragma unroll
                        for (int e = 0; e < 4; ++e) { const float a = fmaxf(v0[e], 0.f), b = fmaxf(v1[e], 0.f); v0[e] = a * a; v1[e] = b * b; }
                    }
                    u32x4 w; w.x = cvt_pk_bf16(v0[0], v0[1]); w.y = cvt_pk_bf16(v0[2], v0[3]); w.z = cvt_pk_bf16(v1[0], v1[1]); w.w = cvt_pk_bf16(v1[2], v1[3]);
                    st16(O + (size_t)row * ldc + col, w);
                }
            }
    }
};
struct EpiGelu {
    static constexpr bool PERM = true, AFTER_DRAIN = false;
    const float* SSQP; bf16_t* U2; bf16_t* VPRE; float* LNP;
    __device__ __forceinline__ float sk_scale(int row) const { return rstd_row(SSQP, row); }
    __device__ __forceinline__ f32x4 sk_pre(int row, int col) const { return (f32x4){0.f, 0.f, 0.f, 0.f}; }
    __device__ __forceinline__ void sk_elem(int row, int col, f32x4 v, f32x4 pre, float rs, float& s1, float& s2) const {
        v = v * rs;
        const f32x2 a = pg8::gelu_pk((f32x2){v[0], v[1]}), b = pg8::gelu_pk((f32x2){v[2], v[3]});
        v = (f32x4){a.x, a.y, b.x, b.y};
        if (col < SGW) { u32x2 w; w.x = cvt_pk_bf16(v[0], v[1]); w.y = cvt_pk_bf16(v[2], v[3]); *(u32x2*)(U2 + (size_t)row * SGW + col) = w; }
        else { u32x2 w; w.x = cvt_pk_bf16(v[0], v[1]); w.y = cvt_pk_bf16(v[2], v[3]); *(u32x2*)(VPRE + (size_t)row * SGW + (col - SGW)) = w; s1 += (v[0] + v[1]) + (v[2] + v[3]); s2 += (v[0] * v[0] + v[1] * v[1]) + (v[2] * v[2] + v[3] * v[3]); }
    }
    __device__ __forceinline__ void sk_fin(int row, int slot, float s1, float s2) const { if (slot >= 32) { float* lp = LNP + ((size_t)row * 32 + (slot - 32)) * 2; lp[0] = s1; lp[1] = s2; } }
    __device__ __forceinline__ void operator()(EPI_ARGS) const {
        EPI_RS8(rs8, SSQP, u.pm * 256 + wr * 64 + fr);
#pragma unroll
        for (int ai = 0; ai < 2; ++ai)
#pragma unroll
            for (int m = 0; m < 4; ++m) {
                const int row = u.pm * 256 + ai * 128 + wr * 64 + m * 16 + fr; const float rs = rs8[ai][m];
                float s1 = 0.f, s2 = 0.f;
#pragma unroll
                for (int bj = 0; bj < 2; ++bj) {
                    const int col = u.pn * 256 + bj * 128 + wc * 32 + 8 * fq;
                    f32x4 v0 = acc[ai][bj][m][0] * rs, v1 = acc[ai][bj][m][1] * rs;
                    { const f32x2 a = pg8::gelu_pk((f32x2){v0[0], v0[1]}), b = pg8::gelu_pk((f32x2){v0[2], v0[3]}), cc = pg8::gelu_pk((f32x2){v1[0], v1[1]}), d = pg8::gelu_pk((f32x2){v1[2], v1[3]});
                      v0 = (f32x4){a.x, a.y, b.x, b.y}; v1 = (f32x4){cc.x, cc.y, d.x, d.y}; }
                    if (u.pn < 8) {
                        u32x4 w; w.x = cvt_pk_bf16(v0[0], v0[1]); w.y = cvt_pk_bf16(v0[2], v0[3]); w.z = cvt_pk_bf16(v1[0], v1[1]); w.w = cvt_pk_bf16(v1[2], v1[3]);
                        st16(U2 + (size_t)row * SGW + col, w);
                    } else {
                        u32x4 w; w.x = cvt_pk_bf16(v0[0], v0[1]); w.y = cvt_pk_bf16(v0[2], v0[3]); w.z = cvt_pk_bf16(v1[0], v1[1]); w.w = cvt_pk_bf16(v1[2], v1[3]); st16(VPRE + (size_t)row * SGW + (col - SGW), w);
                        s1 += (v0[0] + v0[1]) + (v0[2] + v0[3]) + (v1[0] + v1[1]) + (v1[2] + v1[3]);
                        s2 += (v0[0] * v0[0] + v0[1] * v0[1]) + (v0[2] * v0[2] + v0[3] * v0[3]) + (v1[0] * v1[0] + v1[1] * v1[1]) + (v1[2] * v1[2] + v1[3] * v1[3]);
                    }
                }
                if (u.pn >= 8) {
                    s1 += __shfl_xor(s1, 16); s1 += __shfl_xor(s1, 32); s2 += __shfl_xor(s2, 16); s2 += __shfl_xor(s2, 32);
                    if (fq == 0) { float* lp = LNP + ((size_t)row * 32 + (u.pn - 8) * 4 + wc) * 2; lp[0] = s1; lp[1] = s2; }
                }
            }
    }
};

__device__ __forceinline__ f32x4 mfma16(bf16x8 a, bf16x8 b, f32x4 cc) { return __builtin_amdgcn_mfma_f32_16x16x32_bf16(a, b, cc, 0, 0, 0); }
template <class Epi> __device__ __forceinline__ void skinny_gemm(const Ctx& c, const bf16_t* A, const bf16_t* Bt, int K, int N, const Epi& E) {
    LAS float* red = (LAS float*)c.lds;
    const int ntask = 8 * (N >> 6), lane = c.lane, wv = c.wave, fr = lane & 15, fq = lane >> 4, kw = K >> 3;
    int it = 0;
    for (int t = c.bid; t < ntask; t += c.G, ++it) {
        const int rb = t & 7, cg = t >> 3, row = MP + rb * 16 + fr;
        LAS float* rbuf = red + (it & 1) * 8192;
        float rs = 1.0f; f32x4 pre[4];
#pragma unroll
        for (int nf = 0; nf < 4; ++nf) pre[nf] = (f32x4){0.f, 0.f, 0.f, 0.f};
        if (wv == 0) { rs = E.sk_scale(row);
#pragma unroll
            for (int nf = 0; nf < 4; ++nf) pre[nf] = E.sk_pre(row, cg * 64 + nf * 16 + fq * 4); }
        const bf16_t* ap = A + (size_t)row * K + wv * kw + fq * 8;
        const bf16_t* bp = Bt + (size_t)(cg * 64 + fr) * K + wv * kw + fq * 8;
        f32x4 acc[4];
#pragma unroll
        for (int nf = 0; nf < 4; ++nf) acc[nf] = (f32x4){0.f, 0.f, 0.f, 0.f};
#pragma unroll 1
        for (int k = 0; k < kw; k += 128) {
            bf16x8 af[4], bfr[4][4];
#pragma unroll
            for (int q = 0; q < 4; ++q) {
                af[q] = *(const bf16x8*)(ap + k + q * 32);
#pragma unroll
                for (int nf = 0; nf < 4; ++nf) bfr[q][nf] = *(const bf16x8*)(bp + (size_t)nf * 16 * K + k + q * 32);
            }
            __builtin_amdgcn_sched_barrier(0);
#pragma unroll
            for (int q = 0; q < 4; ++q)
#pragma unroll
                for (int nf = 0; nf < 4; ++nf) acc[nf] = mfma16(bfr[q][nf], af[q], acc[nf]);
        }
#pragma unroll
        for (int nf = 0; nf < 4; ++nf) *(LAS f32x4*)(rbuf + (wv * 64 + lane) * 16 + nf * 4) = acc[nf];
        LDS_BARRIER();
        if (wv == 0) {
            float s1 = 0.f, s2 = 0.f;
#pragma unroll
            for (int nf = 0; nf < 4; ++nf) {
                f32x4 v = *(const LAS f32x4*)(rbuf + lane * 16 + nf * 4);
#pragma unroll
                for (int w = 1; w < 8; ++w) v += *(const LAS f32x4*)(rbuf + (w * 64 + lane) * 16 + nf * 4);
                E.sk_elem(row, cg * 64 + nf * 16 + fq * 4, v, pre[nf], rs, s1, s2);
            }
            s1 += __shfl_xor(s1, 16); s1 += __shfl_xor(s1, 32); s2 += __shfl_xor(s2, 16); s2 += __shfl_xor(s2, 32);
            if (fq == 0) E.sk_fin(row, cg, s1, s2);
        }
    }
    LDS_BARRIER();
}
#define XB_TMO      128
#define XB_XCNT(j)  (256  + 64 * (j))
#define XB_XSUB(j)  (1280 + 64 * (j))
#define XB_XGEN(j)  (2304 + 64 * (j))
#define XB_TOP      3328
#define XB_TOPGEN   3392
#define XCD_BAR_WORDS 3456
#define XB_SPIN_CAP (1u << 18)

__device__ __forceinline__ unsigned xb_ld(unsigned* p)              { return __hip_atomic_load(p, __ATOMIC_RELAXED, __HIP_MEMORY_SCOPE_AGENT); }
__device__ __forceinline__ unsigned xb_add(unsigned* p, unsigned v) { return __hip_atomic_fetch_add(p, v, __ATOMIC_RELAXED, __HIP_MEMORY_SCOPE_AGENT); }
__device__ __forceinline__ unsigned xb_xcc_id() { return (unsigned)__builtin_amdgcn_s_getreg((3 << 11) | 20) & 0xFu; }
#define XB_SPIN(cond, bar) do { unsigned _sp = 0; while (cond) { __builtin_amdgcn_s_sleep(1); \
    if ((++_sp & 255u) == 0u) { if (xb_ld(&(bar)[XB_TMO])) break; if (_sp > XB_SPIN_CAP) { atomicAdd(&(bar)[XB_TMO], 1u); break; } } } } while (0)

struct XcdBarrier {
    unsigned* bar; unsigned x;
    volatile LAS unsigned* st;
};

__device__ __forceinline__ XcdBarrier xcd_barrier_post(unsigned* bar, volatile LAS unsigned* st) {
    XcdBarrier b; b.bar = bar; b.x = xb_xcc_id(); b.st = st;
    if (threadIdx.x == 0) (void)xb_add(&bar[XB_XCNT(b.x)], 1u);
    return b;
}
__device__ __forceinline__ void xcd_barrier_complete(unsigned* bar, unsigned x, unsigned& nloc, unsigned& nx) {
    const unsigned G = gridDim.x * gridDim.y * gridDim.z;
    unsigned sum, cnt, mine, sp = 0u;
    for (;;) {
        sum = 0u; cnt = 0u; mine = 0u;
#pragma unroll
        for (unsigned j = 0; j < 16; ++j) { const unsigned c = xb_ld(&bar[XB_XCNT(j)]); sum += c; cnt += (c > 0u) ? 1u : 0u; mine = (j == x) ? c : mine; }
        if (sum == G) break;
        __builtin_amdgcn_s_sleep(1);
        if ((++sp & 255u) == 0u) { if (xb_ld(&bar[XB_TMO])) break; if (sp > XB_SPIN_CAP) { atomicAdd(&bar[XB_TMO], 1u); break; } }
    }
    nloc = mine > 0u ? mine : 1u; nx = cnt > 0u ? cnt : 1u;
}

__device__ __forceinline__ void xcd_barrier(const XcdBarrier& b) {
    asm volatile("s_waitcnt vmcnt(0)" ::: "memory");
    __syncthreads();
    if (threadIdx.x == 0) {
        unsigned* bar = b.bar;
        __builtin_amdgcn_s_waitcnt(0);
        unsigned nloc = b.st[0], nx = b.st[1];
        if (nloc == 0u) { xcd_barrier_complete(bar, b.x, nloc, nx); b.st[0] = nloc; b.st[1] = nx; }
        const unsigned old = xb_add(&bar[XB_XSUB(b.x)], 1u);
        const unsigned gen = old / nloc;
        if (old + 1u == (gen + 1u) * nloc) {
            __builtin_amdgcn_fence(__ATOMIC_RELEASE, "agent");
            asm volatile("s_waitcnt vmcnt(0)" ::: "memory");
            const unsigned og = xb_add(&bar[XB_TOP], 1u);
            const unsigned tg = og / nx;
            if (og + 1u == (tg + 1u) * nx) xb_add(&bar[XB_TOPGEN], 1u);
            else XB_SPIN(xb_ld(&bar[XB_TOPGEN]) == tg, bar);
            __builtin_amdgcn_fence(__ATOMIC_ACQUIRE, "agent");
            xb_add(&bar[XB_XGEN(b.x)], 1u);
            asm volatile("s_waitcnt vmcnt(0)" ::: "memory");
        } else {
            XB_SPIN(xb_ld(&bar[XB_XGEN(b.x)]) == gen, bar);
            __builtin_amdgcn_fence(__ATOMIC_ACQUIRE, "agent");
            asm volatile("s_waitcnt vmcnt(0)" ::: "memory");
        }
    }
    __syncthreads();
}


constexpr int DA_PITCH = 520, LA_PITCH = 264;
#define ZL4(ptr) EpiRes::cvt4(*(const u32x2*)(ptr))
__device__ __forceinline__ void phase_pool_prep_impl(const Ctx& c, const bf16_t* __restrict__ Z, bf16_t* __restrict__ CAT, float* __restrict__ SC, float* __restrict__ GATE, float* __restrict__ outp) {
    const bf16_t* POOLWT = WSP(bf16_t, OFF_POOLWT); const bf16_t* W2T = WSP(bf16_t, OFF_W2T); const bf16_t* A2T = WSP(bf16_t, OFF_A2T); const bf16_t* G2T = WSP(bf16_t, OFF_G2T);
    const float* state_pool = c.in[5]; const float* state_shift = c.in[6];
    const float* pool_scale = c.in[16]; const float* mu = c.in[17]; const float* w0 = c.in[18]; const float* a0 = c.in[20];
    const float* k_k = c.in[23]; const float* k_a = c.in[24];
    LAS bf16_t* dA = (LAS bf16_t*)c.lds;
    LAS bf16_t* LA = (LAS bf16_t*)(c.lds + 32 * DA_PITCH * 2);
    const int tid = c.tid, lane = c.lane, wv = c.wave, fr = lane & 15, fq = lane >> 4;
    LAS float* PAR = (LAS float*)(c.lds + 32 * DA_PITCH * 2 + 32 * LA_PITCH * 2);
    for (int i = tid; i < 3840; i += 512) PAR[i] = i < 1792 ? mu[i] : (i < 2304 ? k_k[i - 1792] : (i < 2816 ? a0[i - 2304] : (i < 3328 ? w0[i - 2816] : k_a[i - 3328])));
    LDS_BARRIER();
    for (int tile = c.bid; tile < MP / 32 + MS / 16; tile += c.G) {
        const bool samp = tile >= MP / 32; const int R0 = samp ? MP + (tile - MP / 32) * 16 : tile * 32; const int nmf = samp ? 1 : 2;
        {
            const int cgi = tid & 127, rp = tid >> 7, col = cgi * 4, gi = cgi >> 5, w = 2 << gi;
            if (!samp) {
                const int r0 = R0 + rp * 8, pos0 = r0 & (SEQ - 1);
                f32x4 t[23];
#pragma unroll
                for (int j = 0; j < 23; ++j) {
                    const bool need = (j >= 16 - w) && (pos0 - 15 + j >= 0);
                    t[j] = need ? ZL4(Z + (size_t)(r0 - 15 + j) * ABIN + col) : (f32x4){0.f, 0.f, 0.f, 0.f};
                }
#pragma unroll
                for (int rr = 0; rr < 8; ++rr) {
                    const int R = r0 + rr, pos = pos0 + rr;
                    f32x4 s = t[15 + rr];
#pragma unroll
                    for (int i = 1; i < 16; ++i) if (i < w) s += t[15 + rr - i];
                    const int np = pos < (w - 1) ? pos : (w - 1);
                    const f32x4 zc = t[15 + rr];
                    if (pos >= SEQ - 15) *(f32x4*)(outp + O_PP + ((size_t)(R >> 11) * 15 + (pos - (SEQ - 15))) * PW + col) = zc;
                    const f32x4 d = s * (1.0f / (float)(np + 1)) - zc;
                    u32x2 pk; pk.x = cvt_pk_bf16(d[0], d[1]); pk.y = cvt_pk_bf16(d[2], d[3]);
                    *(LAS u32x2*)(dA + (rp * 8 + rr) * DA_PITCH + col) = pk;
                }
            } else if (rp < 2) {
                for (int rr = 0; rr < 8; ++rr) {
                    const int r = rp * 8 + rr, R = R0 + r, b = R - MP;
                    const f32x4 zc = ZL4(Z + (size_t)R * ABIN + col);
                    f32x4 hb[15];
#pragma unroll
                    for (int j = 0; j < 15; ++j) hb[j] = *(const f32x4*)(state_pool + ((size_t)b * 15 + j) * PW + col);
                    f32x4 s = zc;
#pragma unroll
                    for (int i = 1; i < 16; ++i) if (i < w) s += hb[15 - i];
                    const f32x4 d = s * (1.0f / (float)w) - zc;
                    u32x2 pk; pk.x = cvt_pk_bf16(d[0], d[1]); pk.y = cvt_pk_bf16(d[2], d[3]);
                    *(LAS u32x2*)(dA + r * DA_PITCH + col) = pk;
                }
            }
        }
        if ((tid >> 4) < nmf * 16) {
            const int r = tid >> 4, c0 = (tid & 15) * 16, R = R0 + r;
            const bf16_t* zc = Z + (size_t)R * ABIN + PW + 1536 + c0;
            const bool hasp = samp || (R & (SEQ - 1)) != 0;
            const bf16_t* zp = Z + (size_t)(R - (hasp && !samp ? 1 : 0)) * ABIN + PW + 1536 + c0;
            const float* zpf = state_shift + (size_t)(samp ? R - MP : 0) * RIN + 1536 + c0;
            float f[16];
#pragma unroll
            for (int q = 0; q < 4; ++q) {
                const f32x4 a = ZL4(zc + q * 4); f32x4 p = samp ? *(const f32x4*)(zpf + q * 4) : ZL4(zp + q * 4); const f32x4 m4 = *(const LAS f32x4*)(PAR + 1536 + c0 + q * 4);
                if (!hasp) p = (f32x4){0.f, 0.f, 0.f, 0.f};
                const f32x4 zs = a + (p - a) * m4;
#pragma unroll
                for (int e = 0; e < 4; ++e) f[q * 4 + e] = c0 < 64 ? tanhf_(zs[e]) : (c0 < 128 ? zs[e] : sigmoidf_(zs[e]));
            }
            u32x4 w0_, w1_;
            w0_.x = cvt_pk_bf16(f[0], f[1]); w0_.y = cvt_pk_bf16(f[2], f[3]); w0_.z = cvt_pk_bf16(f[4], f[5]); w0_.w = cvt_pk_bf16(f[6], f[7]);
            w1_.x = cvt_pk_bf16(f[8], f[9]); w1_.y = cvt_pk_bf16(f[10], f[11]); w1_.z = cvt_pk_bf16(f[12], f[13]); w1_.w = cvt_pk_bf16(f[14], f[15]);
            *(LAS u32x4*)(LA + r * LA_PITCH + c0) = w0_; *(LAS u32x4*)(LA + r * LA_PITCH + c0 + 8) = w1_;
            if (!samp) {
                if (((R0 + 31) & (SEQ - 1)) == SEQ - 1 && tid < RIN / 4)
                    *(f32x4*)(outp + O_SHP + (size_t)(R0 >> 11) * RIN + tid * 4) = ZL4(Z + (size_t)(R0 + 31) * ABIN + PW + tid * 4);
            }
        }
        LDS_BARRIER();
        {
            const int gi = wv >> 1, nh = wv & 1;
            f32x4 acc[2][4];
#pragma unroll
            for (int a = 0; a < 2; ++a)
#pragma unroll
                for (int b = 0; b < 4; ++b) acc[a][b] = (f32x4){0.f, 0.f, 0.f, 0.f};
            {
                bf16x8 bw[4][4];
#pragma unroll
                for (int ks = 0; ks < 4; ++ks)
#pragma unroll
                    for (int nf = 0; nf < 4; ++nf) bw[ks][nf] = *(const bf16x8*)(POOLWT + ((size_t)(gi * 128 + nh * 64 + nf * 16 + fr)) * 128 + ks * 32 + fq * 8);
                __builtin_amdgcn_sched_barrier(0);
#pragma unroll
                for (int ks = 0; ks < 4; ++ks) {
                    bf16x8 af[2];
#pragma unroll
                    for (int mf = 0; mf < 2; ++mf) af[mf] = *(const LAS bf16x8*)(dA + (mf * 16 + fr) * DA_PITCH + gi * 128 + ks * 32 + fq * 8);
#pragma unroll
                    for (int nf = 0; nf < 4; ++nf)
#pragma unroll
                        for (int mf = 0; mf < 2; ++mf) acc[mf][nf] = mfma16(bw[ks][nf], af[mf], acc[mf][nf]);
                }
            }
            __builtin_amdgcn_sched_barrier(0);
#pragma unroll
            for (int mf = 0; mf < 2; ++mf)
#pragma unroll
                for (int nf = 0; nf < 4; ++nf) if (mf < nmf) {
                    const int R = R0 + mf * 16 + fr, co = gi * 128 + nh * 64 + nf * 16 + fq * 4;
                    const f32x4 sc = *(const f32x4*)(pool_scale + co); const f32x4 v = acc[mf][nf] * sc;
                    u32x2 pk; pk.x = cvt_pk_bf16(v[0], v[1]); pk.y = cvt_pk_bf16(v[2], v[3]);
                    *(u32x2*)(CAT + (size_t)R * DM + co) = pk;
                }
        }
        __builtin_amdgcn_sched_barrier(0);
        {
            const int h = wv;
#pragma unroll 1
            for (int mf = 0; mf < nmf; ++mf) {
                f32x4 aw[4], aa[4];
#pragma unroll
                for (int b = 0; b < 4; ++b) { aw[b] = (f32x4){0.f, 0.f, 0.f, 0.f}; aa[b] = aw[b]; }
                {
                    bf16x8 bw[2][4], ba[2][4];
#pragma unroll
                    for (int ks = 0; ks < 2; ++ks)
#pragma unroll
                        for (int nf = 0; nf < 4; ++nf) {
                            bw[ks][nf] = *(const bf16x8*)(W2T + (size_t)(h * 64 + nf * 16 + fr) * 64 + ks * 32 + fq * 8);
                            ba[ks][nf] = *(const bf16x8*)(A2T + (size_t)(h * 64 + nf * 16 + fr) * 64 + ks * 32 + fq * 8);
                        }
                    __builtin_amdgcn_sched_barrier(0);
#pragma unroll
                    for (int ks = 0; ks < 2; ++ks) {
                        const bf16x8 af = *(const LAS bf16x8*)(LA + (mf * 16 + fr) * LA_PITCH + ks * 32 + fq * 8);
                        const bf16x8 ag_ = *(const LAS bf16x8*)(LA + (mf * 16 + fr) * LA_PITCH + 64 + ks * 32 + fq * 8);
#pragma unroll
                        for (int nf = 0; nf < 4; ++nf) { aw[nf] = mfma16(bw[ks][nf], af, aw[nf]); aa[nf] = mfma16(ba[ks][nf], ag_, aa[nf]); }
                    }
                }
                __builtin_amdgcn_sched_barrier(0);
                const int R = R0 + mf * 16 + fr;
                const bf16_t* zc = Z + (size_t)R * ABIN + PW;
                const bool hasp = samp || (R & (SEQ - 1)) != 0;
                const bf16_t* zp = Z + (size_t)(R - (hasp && !samp ? 1 : 0)) * ABIN + PW;
                const float* zpf = state_shift + (size_t)(samp ? R - MP : 0) * RIN;
#define ZLOAD4(dst, base) do { f32x4 a_[4], p_[4]; \
                    _Pragma("unroll") for (int nf = 0; nf < 4; ++nf) { const int cx = (base) + h * 64 + nf * 16 + fq * 4; a_[nf] = ZL4(zc + cx); p_[nf] = samp ? *(const f32x4*)(zpf + cx) : ZL4(zp + cx); } \
                    _Pragma("unroll") for (int nf = 0; nf < 4; ++nf) { const int cx = (base) + h * 64 + nf * 16 + fq * 4; if (!hasp) p_[nf] = (f32x4){0.f, 0.f, 0.f, 0.f}; \
                        dst[nf] = a_[nf] + (p_[nf] - a_[nf]) * *(const LAS f32x4*)(PAR + cx); } } while (0)
                f32x4 k4[4], kk4[4], r4[4], v4[4]; float ss = 0.f;
                ZLOAD4(k4, 512);
                __builtin_amdgcn_sched_barrier(0);
                ZLOAD4(r4, 0);
                __builtin_amdgcn_sched_barrier(0);
                ZLOAD4(v4, 1024);
                __builtin_amdgcn_sched_barrier(0);
#pragma unroll
                for (int nf = 0; nf < 4; ++nf) {
                    kk4[nf] = k4[nf] * *(const LAS f32x4*)(PAR + 1792 + h * 64 + nf * 16 + fq * 4);
                    ss += (kk4[nf][0] * kk4[nf][0] + kk4[nf][1] * kk4[nf][1]) + (kk4[nf][2] * kk4[nf][2] + kk4[nf][3] * kk4[nf][3]);
                }
                ss += __shfl_xor(ss, 16); ss += __shfl_xor(ss, 32);
                const float inv = 1.0f / fmaxf(sqrtf(ss), 1e-12f);
                float* scb = SC + ((size_t)(R >> 4) * 8 + h) * 6144 + (R & 15) * 16 + fq * 4;
#pragma unroll
                for (int nf = 0; nf < 4; ++nf) {
                    const int off = nf * 16 + fq * 4;
                    const f32x4 a0v = *(const LAS f32x4*)(PAR + 2304 + h * 64 + off), w0v = *(const LAS f32x4*)(PAR + 2816 + h * 64 + off), kav = *(const LAS f32x4*)(PAR + 3328 + h * 64 + off);
                    f32x4 a4, dec;
#pragma unroll
                    for (int e = 0; e < 4; ++e) { a4[e] = sigmoidf_(a0v[e] + aa[nf][e]); dec[e] = __expf(-0.6065306597126334f * sigmoidf_(w0v[e] + aw[nf][e])); }
                    const f32x4 kkn = kk4[nf] * inv, kp = k4[nf] * (1.0f + (a4 - 1.0f) * kav);
                    *(f32x4*)(scb + nf * 256) = -kkn; *(f32x4*)(scb + 1024 + nf * 256) = dec; *(f32x4*)(scb + 2048 + nf * 256) = kkn * a4;
                    *(f32x4*)(scb + 3072 + nf * 256) = kp; *(f32x4*)(scb + 4096 + nf * 256) = r4[nf]; *(f32x4*)(scb + 5120 + nf * 256) = v4[nf];
                }
#undef ZLOAD4
            }
            {
                f32x4 ag[2][4];
#pragma unroll
                for (int a = 0; a < 2; ++a)
#pragma unroll
                    for (int b = 0; b < 4; ++b) ag[a][b] = (f32x4){0.f, 0.f, 0.f, 0.f};
                {
                    bf16x8 bg[4][4];
#pragma unroll
                    for (int ks = 0; ks < 4; ++ks)
#pragma unroll
                        for (int nf = 0; nf < 4; ++nf) bg[ks][nf] = *(const bf16x8*)(G2T + (size_t)(h * 64 + nf * 16 + fr) * 128 + ks * 32 + fq * 8);
                    __builtin_amdgcn_sched_barrier(0);
#pragma unroll
                    for (int ks = 0; ks < 4; ++ks) {
                        bf16x8 af[2];
#pragma unroll
                        for (int mf = 0; mf < 2; ++mf) af[mf] = *(const LAS bf16x8*)(LA + (mf * 16 + fr) * LA_PITCH + 128 + ks * 32 + fq * 8);
#pragma unroll
                        for (int nf = 0; nf < 4; ++nf)
#pragma unroll
                            for (int mf = 0; mf < 2; ++mf) ag[mf][nf] = mfma16(bg[ks][nf], af[mf], ag[mf][nf]);
                    }
                }
#pragma unroll
                for (int mf = 0; mf < 2; ++mf)
#pragma unroll
                    for (int nf = 0; nf < 4; ++nf) if (mf < nmf) *(f32x4*)(GATE + (size_t)(R0 + mf * 16 + fr) * 512 + h * 64 + nf * 16 + fq * 4) = ag[mf][nf];
            }
        }
        LDS_BARRIER();
    }
}

__device__ __forceinline__ void phase_pool_prep(const Ctx& c) { phase_pool_prep_impl(c, WSP(bf16_t, OFF_Z), WSP(bf16_t, OFF_CAT), WSP(float, OFF_SC), WSP(float, OFF_GATE), c.out); }

__device__ __forceinline__ float rowsum16(float x) {
    x += __builtin_bit_cast(float, __builtin_amdgcn_update_dpp(0, __builtin_bit_cast(int, x), 0x128, 0xf, 0xf, false));
    x += __builtin_bit_cast(float, __builtin_amdgcn_update_dpp(0, __builtin_bit_cast(int, x), 0x124, 0xf, 0xf, false));
    x += __builtin_bit_cast(float, __builtin_amdgcn_update_dpp(0, __builtin_bit_cast(int, x), 0x122, 0xf, 0xf, false));
    x += __builtin_bit_cast(float, __builtin_amdgcn_update_dpp(0, __builtin_bit_cast(int, x), 0x121, 0xf, 0xf, false));
    return x;
}
constexpr int SCAN_CH = 32;
__device__ __forceinline__ void phase_scan(const Ctx& c) {
    const float* SC = WSP(float, OFF_SC); float* YR = WSP(float, OFF_YR);
    LAS float* buf = (LAS float*)c.lds;
    const int tid = c.tid, lane = c.lane, wv = c.wave;
    for (int ub = c.bid; ub < 256; ub += c.G) {
        const int unit = (c.G == 256) ? ((ub & 7) * 32 + (ub >> 3)) : ub;
        const int bh = unit >> 2, rg = unit & 3, b = bh >> 3, h = bh & 7;
        const float* src = SC + ((size_t)(b * (SEQ / 16)) * 8 + h) * 6144;
#define SC_DEC(idx_, rbi_, arr_, nf_, fr_, q4_) const int rbi_ = (idx_) / 1536, rem_##idx_ = (idx_) % 1536, arr_ = rem_##idx_ >> 8, nf_ = (rem_##idx_ >> 6) & 3, fr_ = (rem_##idx_ >> 2) & 15, q4_ = rem_##idx_ & 3
        const int v = rg * 16 + (wv & 3) * 4 + (lane >> 4), k0 = (lane & 15) * 4;
        f32x4 S = (f32x4){0.f, 0.f, 0.f, 0.f}; float ykeep = 0.f;
        if (wv < 4) __builtin_amdgcn_s_setprio(3); else __builtin_amdgcn_s_setprio(0);
        if (wv >= 4) {
            const int lt = tid - 256;
#pragma unroll
            for (int i = 0; i < 12; ++i) { const int idx = lt + i * 256; SC_DEC(idx, rbi, arr, nf, fr2, q4);
                *(LAS f32x4*)(buf + (rbi * 16 + fr2) * 384 + arr * 64 + nf * 16 + q4 * 4) = *(const f32x4*)(src + (size_t)rbi * 49152 + (size_t)(idx % 1536) * 4); }
        }
        LDS_BARRIER();
        for (int ch = 0; ch < SEQ / SCAN_CH; ++ch) {
            if (wv >= 4) {
                if (ch + 1 < SEQ / SCAN_CH) {
                    const int lt = tid - 256; LAS float* bb = buf + ((ch + 1) & 1) * (SCAN_CH * 384);
                    f32x4 t[12];
#pragma unroll
                    for (int i = 0; i < 12; ++i) { const int idx = lt + i * 256; t[i] = *(const f32x4*)(src + (size_t)((ch + 1) * 2 + idx / 1536) * 49152 + (size_t)(idx % 1536) * 4); }
#pragma unroll
                    for (int i = 0; i < 12; ++i) { const int idx = lt + i * 256; SC_DEC(idx, rbi, arr, nf, fr2, q4); *(LAS f32x4*)(bb + (rbi * 16 + fr2) * 384 + arr * 64 + nf * 16 + q4 * 4) = t[i]; }
                }
            } else {
                const LAS float* bb = buf + (ch & 1) * (SCAN_CH * 384);
                f32x4 pn[3][5]; float pv[3];
#define SCAN_LD(slot, s_) do { const LAS float* p_ = bb + (s_) * 384; pn[slot][0] = *(const LAS f32x4*)(p_ + k0); pn[slot][1] = *(const LAS f32x4*)(p_ + 64 + k0); \
                    pn[slot][2] = *(const LAS f32x4*)(p_ + 128 + k0); pn[slot][3] = *(const LAS f32x4*)(p_ + 192 + k0); pn[slot][4] = *(const LAS f32x4*)(p_ + 256 + k0); pv[slot] = p_[320 + v]; } while (0)
                SCAN_LD(0, 0); SCAN_LD(1, 1);
#pragma unroll
                for (int s = 0; s < SCAN_CH; ++s) {
                    if (s + 2 < SCAN_CH) SCAN_LD((s + 2) % 3, s + 2);
                    const f32x4 nkk = pn[s % 3][0], d = pn[s % 3][1], ka = pn[s % 3][2], kp = pn[s % 3][3], r = pn[s % 3][4];
                    const float vv = pv[s % 3];
                    const float sa = rowsum16((S[0] * nkk[0] + S[1] * nkk[1]) + (S[2] * nkk[2] + S[3] * nkk[3]));
                    S = S * d + ka * sa + kp * vv;
                    const float y = rowsum16((S[0] * r[0] + S[1] * r[1]) + (S[2] * r[2] + S[3] * r[3]));
                    ykeep = ((s & 15) == (lane & 15)) ? y : ykeep;
                    if ((s & 15) == 15) YR[((size_t)b * SEQ + ch * SCAN_CH + (s - 15) + (lane & 15)) * 512 + h * 64 + v] = ykeep;
                }
#undef SCAN_LD
            }
            LDS_BARRIER();
        }
        if (wv < 4) *(f32x4*)(c.out + O_WKP + (((size_t)b * 8 + h) * 64 + v) * 64 + k0) = S;
        __builtin_amdgcn_s_setprio(0);
    }
    const float* swkv = c.in[7];
    for (int unit = c.bid; unit < MS * 8; unit += c.G) {
        const int b = unit >> 3, h = unit & 7, v = tid >> 3, k0 = (tid & 7) * 8;
        const size_t so = (((size_t)b * 8 + h) * 64 + v) * 64 + k0;
        f32x4 S0 = *(const f32x4*)(swkv + so), S1 = *(const f32x4*)(swkv + so + 4);
        const float* pb_ = SC + ((size_t)((MP + b) >> 4) * 8 + h) * 6144 + ((MP + b) & 15) * 16;
        const float* p = pb_ + (k0 >> 4) * 256 + (k0 & 15);
        const f32x4 n0 = *(const f32x4*)(p), n1 = *(const f32x4*)(p + 4), d0 = *(const f32x4*)(p + 1024), d1 = *(const f32x4*)(p + 1024 + 4),
                    a0_ = *(const f32x4*)(p + 2048), a1_ = *(const f32x4*)(p + 2048 + 4), kp0 = *(const f32x4*)(p + 3072), kp1 = *(const f32x4*)(p + 3072 + 4),
                    r0 = *(const f32x4*)(p + 4096), r1 = *(const f32x4*)(p + 4096 + 4);
        const float vv = pb_[5120 + (v >> 4) * 256 + (v & 15)];
        float sa = (S0[0] * n0[0] + S0[1] * n0[1]) + (S0[2] * n0[2] + S0[3] * n0[3]) + (S1[0] * n1[0] + S1[1] * n1[1]) + (S1[2] * n1[2] + S1[3] * n1[3]);
        sa += __shfl_xor(sa, 1); sa += __shfl_xor(sa, 2); sa += __shfl_xor(sa, 4);
        S0 = S0 * d0 + a0_ * sa + kp0 * vv; S1 = S1 * d1 + a1_ * sa + kp1 * vv;
        float y = (S0[0] * r0[0] + S0[1] * r0[1]) + (S0[2] * r0[2] + S0[3] * r0[3]) + (S1[0] * r1[0] + S1[1] * r1[1]) + (S1[2] * r1[2] + S1[3] * r1[3]);
        y += __shfl_xor(y, 1); y += __shfl_xor(y, 2); y += __shfl_xor(y, 4);
        *(f32x4*)(c.out + O_WKS + so) = S0; *(f32x4*)(c.out + O_WKS + so + 4) = S1;
        if ((tid & 7) == 0) YR[(size_t)(MP + b) * 512 + h * 64 + v] = y;
    }
}

__device__ __forceinline__ void phase_post(const Ctx& c) {
    const float* SC = WSP(float, OFF_SC); const float* YR = WSP(float, OFF_YR); const float* GATE = WSP(float, OFF_GATE); bf16_t* CAT = WSP(bf16_t, OFF_CAT);
    const float* r_k = c.in[25]; const float* gn_g = c.in[26]; const float* gn_b = c.in[27];
    const int gw = c.bid * 8 + c.wave, nw = c.G * 8, l16 = c.lane & 15, hq = c.lane >> 4;
    for (int t = gw; t < MR * 2; t += nw) {
        const int R = t >> 1, h = (t & 1) * 4 + hq, cc = h * 64 + l16 * 4;
        const float* p = SC + ((size_t)(R >> 4) * 8 + h) * 6144 + (l16 >> 2) * 256 + (R & 15) * 16 + (l16 & 3) * 4;
        const f32x4 y = *(const f32x4*)(YR + (size_t)R * 512 + cc), kp = *(const f32x4*)(p + 3072), r = *(const f32x4*)(p + 4096), v = *(const f32x4*)(p + 5120);
        const f32x4 g = *(const f32x4*)(GATE + (size_t)R * 512 + cc), rk = *(const f32x4*)(r_k + cc), gg = *(const f32x4*)(gn_g + cc), gb = *(const f32x4*)(gn_b + cc);
        const float m = rowsum16((y[0] + y[1]) + (y[2] + y[3])) * (1.0f / 64.0f);
        const f32x4 dl = y - m;
        const float var = rowsum16((dl[0] * dl[0] + dl[1] * dl[1]) + (dl[2] * dl[2] + dl[3] * dl[3])) * (1.0f / 64.0f);
        const float bs = rowsum16((r[0] * kp[0] * rk[0] + r[1] * kp[1] * rk[1]) + (r[2] * kp[2] * rk[2] + r[3] * kp[3] * rk[3]));
        const f32x4 o = (dl * rsqrtf(var + GN_EPS) * gg + gb + v * bs) * g;
        u32x2 pk; pk.x = cvt_pk_bf16(o[0], o[1]); pk.y = cvt_pk_bf16(o[2], o[3]);
        *(u32x2*)(CAT + (size_t)R * DM + 512 + cc) = pk;
    }
}

__device__ __forceinline__ void phase_attn(const Ctx& c, int l, int amask = 3) {
    const bf16_t* Q = WSP(bf16_t, OFF_Q); bf16_t* OAT = WSP(bf16_t, OFF_OAT);
    const bf16_t* KB = WSP(bf16_t, OFF_KB) + (size_t)l * 2048 * 1024; const bf16_t* VT = WSP(bf16_t, OFF_VT) + (size_t)l * 2048 * 1024;
    const float* ck = c.in[3] + (size_t)l * MS * 256 * 1024; const float* cv = c.in[4] + (size_t)l * MS * 256 * 1024;
    const int tid = c.tid, lane = c.lane, wv = c.wave, fr = lane & 15, fq = lane >> 4;
    LAS float* sc = (LAS float*)(c.lds + 73728);
    LAS float* red = (LAS float*)(c.lds + 73728 + 1024);
    const int NPU = 512, NSU = 512;
    const int nround = (NPU + NSU + c.G - 1) / c.G; const bool rev = ((c.bid >> 3) & 1) != 0;
    for (int kk = 0; kk < nround; ++kk) {
        const int unit = c.bid + (rev ? nround - 1 - kk : kk) * c.G;
        if (unit >= NPU + NSU) continue;
        if (!((amask >> (unit >= NPU)) & 1)) continue;
        if (unit < NPU) {
            const int b = unit >> 6, h = (unit >> 4) & 3, qb = unit & 15;
            const int R0 = b * SEQ + qb * 128 + wv * 16;
            const bf16_t* kg = KB + (size_t)(b * 256) * DM + h * 256;
            const bf16_t* vg = VT + ((size_t)(b * 4 + h) * 256) * 256;
            bf16x8 qf[8];
#pragma unroll
            for (int ks = 0; ks < 8; ++ks) qf[ks] = *(const bf16x8*)(Q + (size_t)(R0 + fr) * DM + h * 256 + ks * 32 + fq * 8);
            u32x4 st[4];
#define ATT_LOAD(ti) do { _Pragma("unroll") for (int i = 0; i < 4; ++i) { const int q = tid + i * 512; \
                if ((ti) < 4) st[i] = *(const u32x4*)(kg + (size_t)((ti) * 64 + (q >> 5)) * DM + (q & 31) * 8); \
                else st[i] = *(const u32x4*)(vg + (size_t)(q >> 3) * 256 + ((ti) - 4) * 64 + (q & 7) * 8); } } while (0)
#define ATT_STORE(ti, bufp) do { _Pragma("unroll") for (int i = 0; i < 4; ++i) { const int q = tid + i * 512; \
                if ((ti) < 4) *(LAS u32x4*)((bufp) + (q >> 5) * 528 + (q & 31) * 16) = st[i]; \
                else *(LAS u32x4*)((bufp) + (q >> 3) * 144 + (q & 7) * 16) = st[i]; } } while (0)
            ATT_LOAD(0); ATT_STORE(0, c.lds);
            LDS_BARRIER();
            f32x4 s[16]; f32x4 o[16]; bf16x8 pf[8]; float inv = 1.f;
#pragma unroll
            for (int i = 0; i < 16; ++i) { s[i] = (f32x4){0.f, 0.f, 0.f, 0.f}; o[i] = (f32x4){0.f, 0.f, 0.f, 0.f}; }
#pragma unroll
            for (int ti = 0; ti < 8; ++ti) {
                LAS unsigned char* cur = c.lds + (ti & 1) * 36864; LAS unsigned char* nxt = c.lds + ((ti + 1) & 1) * 36864;
                if (ti + 1 < 8) ATT_LOAD(ti + 1);
                if (ti < 4) {
#pragma unroll
                    for (int n4 = 0; n4 < 4; ++n4)
#pragma unroll
                        for (int ks = 0; ks < 8; ++ks) {
                            const bf16x8 kf = *(const LAS bf16x8*)(cur + (n4 * 16 + fr) * 528 + (ks * 32 + fq * 8) * 2);
                            s[ti * 4 + n4] = mfma16(kf, qf[ks], s[ti * 4 + n4]);
                        }
                    if (ti == 3) {
                        float mx = -3.0e38f;
#pragma unroll
                        for (int nf = 0; nf < 16; ++nf) mx = fmaxf(mx, fmaxf(fmaxf(s[nf][0], s[nf][1]), fmaxf(s[nf][2], s[nf][3])));
                        mx = fmaxf(mx, __shfl_xor(mx, 16)); mx = fmaxf(mx, __shfl_xor(mx, 32));
                        float sum = 0.f;
#pragma unroll
                        for (int nf = 0; nf < 16; ++nf)
#pragma unroll
                            for (int e = 0; e < 4; ++e) { const float p = exp2f(s[nf][e] - mx); s[nf][e] = p; sum += p; }
                        sum += __shfl_xor(sum, 16); sum += __shfl_xor(sum, 32);
                        inv = 1.0f / sum;
#pragma unroll
                        for (int ks = 0; ks < 8; ++ks) {
                            u32x4 w; w.x = cvt_pk_bf16(s[2 * ks][0], s[2 * ks][1]); w.y = cvt_pk_bf16(s[2 * ks][2], s[2 * ks][3]);
                            w.z = cvt_pk_bf16(s[2 * ks + 1][0], s[2 * ks + 1][1]); w.w = cvt_pk_bf16(s[2 * ks + 1][2], s[2 * ks + 1][3]);
                            pf[ks] = __builtin_bit_cast(bf16x8, w);
                        }
                    }
                } else {
                    const int mt = ti - 4;
#pragma unroll
                    for (int nfd = 0; nfd < 16; ++nfd)
#pragma unroll
                        for (int kl = 0; kl < 2; ++kl) {
                            const LAS unsigned char* vp = cur + (nfd * 16 + fr) * 144 + (kl * 32 + fq * 4) * 2;
                            const u32x2 lo = *(const LAS u32x2*)vp, hi = *(const LAS u32x2*)(vp + 32);
                            u32x4 w; w.x = lo.x; w.y = lo.y; w.z = hi.x; w.w = hi.y;
                            o[nfd] = mfma16(__builtin_bit_cast(bf16x8, w), pf[2 * mt + kl], o[nfd]);
                        }
                }
                if (ti + 1 < 8) ATT_STORE(ti + 1, nxt);
                LDS_BARRIER();
            }
#undef ATT_LOAD
#undef ATT_STORE
#pragma unroll
            for (int nfd = 0; nfd < 16; ++nfd) {
                const f32x4 ov = o[nfd] * inv;
                u32x2 pk; pk.x = cvt_pk_bf16(ov[0], ov[1]); pk.y = cvt_pk_bf16(ov[2], ov[3]);
                *(u32x2*)(OAT + (size_t)(R0 + fr) * DM + h * 256 + nfd * 16 + fq * 4) = pk;
            }
        } else {
            const int su = unit - NPU, b = su >> 2, h = su & 3, R = MP + b;
            const int l16 = lane & 15, rj = lane >> 4;
            f32x4 q4[4];
#pragma unroll
            for (int i = 0; i < 4; ++i) { const u32x2 qraw = *(const u32x2*)(Q + (size_t)R * DM + h * 256 + (i * 16 + l16) * 4);
                q4[i] = (f32x4){__uint_as_float(qraw.x << 16), __uint_as_float(qraw.x & 0xffff0000u), __uint_as_float(qraw.y << 16), __uint_as_float(qraw.y & 0xffff0000u)}; }
            const float* kb = ck + ((size_t)b * 256 * 4 + h) * 256;
            const float* vbp = cv + ((size_t)b * 256 * 4 + h) * 256 + lane * 4;
#pragma unroll
            for (int gh = 0; gh < 2; ++gh) {
                f32x4 kv[4][4];
#pragma unroll
                for (int g = 0; g < 4; ++g)
#pragma unroll
                    for (int i = 0; i < 4; ++i) kv[g][i] = *(const f32x4*)(kb + (size_t)(wv * 32 + (gh * 4 + g) * 4 + rj) * 1024 + (i * 16 + l16) * 4);
#pragma unroll
                for (int g = 0; g < 4; ++g) {
                    float d = 0.f;
#pragma unroll
                    for (int i = 0; i < 4; ++i) d += (kv[g][i][0] * q4[i][0] + kv[g][i][1] * q4[i][1]) + (kv[g][i][2] * q4[i][2] + kv[g][i][3] * q4[i][3]);
                    d = rowsum16(d);
                    if (l16 == 0) sc[wv * 32 + (gh * 4 + g) * 4 + rj] = d;
                }
            }
            LDS_BARRIER();
            const f32x4 s4 = *(const LAS f32x4*)(sc + lane * 4);
            const float mx = wave_max(fmaxf(fmaxf(s4[0], s4[1]), fmaxf(s4[2], s4[3])));
            const float sum = wave_sum((exp2f(s4[0] - mx) + exp2f(s4[1] - mx)) + (exp2f(s4[2] - mx) + exp2f(s4[3] - mx)));
            f32x4 acc = (f32x4){0.f, 0.f, 0.f, 0.f};
            for (int mi = 0; mi < 32; mi += 16) {
                f32x4 vv[16];
#pragma unroll
                for (int e = 0; e < 16; ++e) vv[e] = *(const f32x4*)(vbp + (size_t)(wv * 32 + mi + e) * 1024);
#pragma unroll
                for (int e = 0; e < 16; ++e) { const float p = exp2f(sc[wv * 32 + mi + e] - mx); acc += vv[e] * p; }
            }
            *(LAS f32x4*)(red + wv * 256 + lane * 4) = acc;
            LDS_BARRIER();
            if (tid < 256) {
                float o = 0.f;
#pragma unroll
                for (int w = 0; w < 8; ++w) o += red[w * 256 + tid];
                OAT[(size_t)R * DM + h * 256 + tid] = (bf16_t)cvt_pk_bf16(o / sum, 0.f);
            }
            LDS_BARRIER();
        }
    }
}

constexpr int SP_PITCH = 132;
__device__ __forceinline__ void phase_spatial(const Ctx& c) {
    const bf16_t* VPRE = WSP(bf16_t, OFF_VPRE); const float* LNP = WSP(float, OFF_LNP); const bf16_t* U2 = WSP(bf16_t, OFF_U2); bf16_t* G2 = WSP(bf16_t, OFF_G2);
    const float* ln_g = c.in[29]; const float* ln_b = c.in[30]; const float* w_s = c.in[31]; const float* b_s = c.in[32];
    LAS float* Wm = (LAS float*)c.lds;
    LAS float* Vn = (LAS float*)(c.lds + 128 * SP_PITCH * 4);
    LAS float* st = (LAS float*)(c.lds + 2 * 128 * SP_PITCH * 4);
    const int tid = c.tid, lane = c.lane, wv = c.wave, fr = lane & 15, fq = lane >> 4;
    int curg = -1;
    f32x4 pvt[8]; f32x4 lng[8], lnb[8];
    LAS float* st2 = st;
#define SP_DECODE(u_, b_, ch_, g_, dq_) const int g_ = (u_) & 3, b_ = (u_) >> 8, ch_ = ((u_) >> 4) & 15, dq_ = ((u_) >> 2) & 3
#define SP_FETCH(u_, sb_) do { SP_DECODE(u_, fb, fch, fg, fdq); const int fR0 = fb * SEQ + fch * 128, fcb = fg * 512 + fdq * 128; \
        _Pragma("unroll") for (int i = 0; i < 8; ++i) { const int idx = tid + i * 512, j = idx >> 5, d4 = (idx & 31) * 4; pvt[i] = EpiRes::cvt4(*(const u32x2*)(VPRE + (size_t)(fR0 + j) * SGW + fcb + d4)); \
            lng[i] = *(const f32x4*)(ln_g + fcb + d4); lnb[i] = *(const f32x4*)(ln_b + fcb + d4); } \
        if (tid < 128) { const float* lp = LNP + (size_t)(fR0 + tid) * 64; float s1 = 0.f, s2 = 0.f; \
            _Pragma("unroll") for (int i = 0; i < 16; ++i) { const f32x4 t = *(const f32x4*)(lp + i * 4); s1 += t[0] + t[2]; s2 += t[1] + t[3]; } \
            const float mean = s1 * (1.0f / 2048.0f), var = fmaxf(s2 * (1.0f / 2048.0f) - mean * mean, 0.f); \
            st2[(sb_) * 256 + tid * 2] = mean; st2[(sb_) * 256 + tid * 2 + 1] = rsqrtf(var + LN_EPS); } } while (0)
#define SP_STORE(sb_) do { _Pragma("unroll") for (int i = 0; i < 8; ++i) { const int idx = tid + i * 512, j = idx >> 5, d4 = (idx & 31) * 4; \
            const float mean = st2[(sb_) * 256 + j * 2], rstd = st2[(sb_) * 256 + j * 2 + 1]; \
            *(LAS f32x4*)(Vn + j * SP_PITCH + d4) = (pvt[i] - mean) * rstd * lng[i] + lnb[i]; } } while (0)
    int it = 0;
    if (c.bid < 2048) { SP_FETCH(c.bid, 0); }
    for (int unit = c.bid; unit < 2048; unit += c.G, ++it) {
        SP_DECODE(unit, b, ch, g, dq);
        const int R0 = b * SEQ + ch * 128, cb = g * 512 + dq * 128;
        if (g != curg) {
            curg = g;
#pragma unroll
            for (int i = 0; i < 8; ++i) {
                const int idx = tid + i * 512, ii = idx >> 5, j4 = (idx & 31) * 4;
                f32x4 v = *(const f32x4*)(w_s + ((size_t)g * 128 + ii) * 128 + j4);
#pragma unroll
                for (int e = 0; e < 4; ++e) if (j4 + e > ii) v[e] = 0.f;
                *(LAS f32x4*)(Wm + ii * SP_PITCH + j4) = v;
            }
        }
        LDS_BARRIER();
        SP_STORE(it & 1);
        LDS_BARRIER();
        if (unit + c.G < 2048) SP_FETCH(unit + c.G, (it + 1) & 1);
        {
            const int p = wv & 3, dh = wv >> 2;
#pragma unroll
            for (int half = 0; half < 2; ++half) {
                const int ib = half ? 7 - p : p;
                f32x4 acc[4];
#pragma unroll
                for (int nf = 0; nf < 4; ++nf) acc[nf] = (f32x4){0.f, 0.f, 0.f, 0.f};
                const int ii = ib * 16 + fr, R = R0 + ii; const float bs = b_s[g * 128 + ii];
                u32x2 ur[4];
#pragma unroll
                for (int nf = 0; nf < 4; ++nf) ur[nf] = *(const u32x2*)(U2 + (size_t)R * SGW + cb + dh * 64 + nf * 16 + fq * 4);
                for (int j0 = 0; j0 < (ib + 1) * 16; j0 += 4) {
                    const float bw = Wm[(ib * 16 + fr) * SP_PITCH + j0 + fq];
#pragma unroll
                    for (int nf = 0; nf < 4; ++nf) {
                        const float av = Vn[(j0 + fq) * SP_PITCH + dh * 64 + nf * 16 + fr];
                        acc[nf] = __builtin_amdgcn_mfma_f32_16x16x4f32(av, bw, acc[nf], 0, 0, 0);
                    }
                }
#pragma unroll
                for (int nf = 0; nf < 4; ++nf) {
                    const int col = cb + dh * 64 + nf * 16 + fq * 4;
                    const f32x4 o = acc[nf] + bs;
                    u32x2 pk; pk.x = cvt_pk_bf16(__uint_as_float(ur[nf].x << 16) * o[0], __uint_as_float(ur[nf].x & 0xffff0000u) * o[1]);
                    pk.y = cvt_pk_bf16(__uint_as_float(ur[nf].y << 16) * o[2], __uint_as_float(ur[nf].y & 0xffff0000u) * o[3]);
                    *(u32x2*)(G2 + (size_t)R * SGW + col) = pk;
                }
            }
        }
    }
    LDS_BARRIER();
#undef SP_DECODE
#undef SP_FETCH
#undef SP_STORE
    const int gw = c.bid * 8 + c.wave, nw = c.G * 8;
    for (int r = gw; r < MS; r += nw) {
        const int R = MP + r;
        const float* lp = LNP + (size_t)R * 64;
        const float t = lane < 32 ? lp[lane * 2] : lp[(lane - 32) * 2 + 1];
        float s = t;
#pragma unroll
        for (int o = 16; o >= 1; o >>= 1) s += __shfl_xor(s, o);
        const float s1 = __shfl(s, 0), s2 = __shfl(s, 32);
        const float mean = s1 * (1.0f / 2048.0f), rstd = rsqrtf(fmaxf(s2 * (1.0f / 2048.0f) - mean * mean, 0.f) + LN_EPS);
#pragma unroll
        for (int i = 0; i < 8; ++i) {
            const int col = i * 256 + lane * 4, g = col >> 9;
            const f32x4 vn = (EpiRes::cvt4(*(const u32x2*)(VPRE + (size_t)R * SGW + col)) - mean) * rstd * *(const f32x4*)(ln_g + col) + *(const f32x4*)(ln_b + col);
            *(f32x4*)(c.out + O_SGV + (size_t)r * SGW + col) = vn;
            const f32x4 o = vn * w_s[(size_t)g * 16384] + b_s[g * 128];
            const u32x2 ur = *(const u32x2*)(U2 + (size_t)R * SGW + col);
            u32x2 pk; pk.x = cvt_pk_bf16(__uint_as_float(ur.x << 16) * o[0], __uint_as_float(ur.x & 0xffff0000u) * o[1]);
            pk.y = cvt_pk_bf16(__uint_as_float(ur.y << 16) * o[2], __uint_as_float(ur.y & 0xffff0000u) * o[3]);
            *(u32x2*)(G2 + (size_t)R * SGW + col) = pk;
        }
    }
}

__device__ __forceinline__ void phase_final(const Ctx& c) {
    const bf16_t* XB = WSP(bf16_t, OFF_XB); const float* SSQP = WSP(float, OFF_SSQP); const float* gf = c.in[12];
    const int gw = c.bid * 8 + c.wave, nw = c.G * 8;
    for (int row = gw; row < MR; row += nw) {
        const float rs = rstd_row(SSQP, row);
        float* o = row < MP ? c.out + O_YP + (size_t)row * DM : c.out + O_YS + (size_t)(row - MP) * DM;
        u32x2 xr[4];
#pragma unroll
        for (int i = 0; i < 4; ++i) xr[i] = *(const u32x2*)(XB + (size_t)row * DM + i * 256 + c.lane * 4);
#pragma unroll
        for (int i = 0; i < 4; ++i) { const int col = i * 256 + c.lane * 4;
            const f32x4 xv = (f32x4){__uint_as_float(xr[i].x << 16), __uint_as_float(xr[i].x & 0xffff0000u), __uint_as_float(xr[i].y << 16), __uint_as_float(xr[i].y & 0xffff0000u)};
            *(f32x4*)(o + col) = xv * rs * *(const f32x4*)(gf + col); }
    }
}

constexpr int NPHASE = 20;
#ifndef PHMASK
#define PHMASK 0xFFFFF
#endif
#define ON(k) ((PHMASK >> (k)) & 1)
#ifndef PROBE_AMASK
#define PROBE_AMASK 3
#endif
#ifndef PROBE_REP
#define PROBE_REP -1
#endif
#define REPS(k) for (int rep_ = 0; rep_ < 1 + (PROBE_REP == (k)); ++rep_)
#ifndef PROBE_GDUP
#define PROBE_GDUP -1
#endif
template <class Epi> __device__ __forceinline__ void run_gemm(const Ctx& c, const bf16_t* A, const bf16_t* Bt, int K, int nN, const Epi& E, bool withmem = false, int phid = -2) {
    pg8::Gemm g{A, Bt, MT, nN * 256, K};
    Order2 S; S.init(MP / 256, nN, c.G, c.bid); if (withmem) S.add(MMEM / 256, 16, MT / 256, 9); if (phid == PROBE_GDUP) S.dup = 2;
    if (nN == 4) pg8::gemm_phase<Epi, Order2, false, true>(c.lds, g, S, E);
    else pg8::gemm_phase<Epi, Order2, true, true>(c.lds, g, S, E);
    skinny_gemm(c, A, Bt, K, nN * 256, E);
}

__global__ void __launch_bounds__(512, 2) mega_fwd(Params prm) {
    extern __shared__ __attribute__((aligned(16))) unsigned char lds_raw[];
    cg::grid_group grid = cg::this_grid();
    Ctx c; c.in = prm.in; c.out = prm.out; c.ws = prm.ws; c.tid = threadIdx.x; c.lane = c.tid & 63; c.wave = __builtin_amdgcn_readfirstlane(c.tid >> 6);
    c.G = gridDim.x; c.bid = blockIdx.x; c.lds = (LAS unsigned char*)lds_raw;
    bf16_t* XB = WSP(bf16_t, OFF_XB); float* SSQP = WSP(float, OFF_SSQP);
    volatile LAS unsigned* bst = (volatile LAS unsigned*)(c.lds + LDS_BYTES - 16);
    if (c.tid < 4) bst[c.tid] = 0u;
    __syncthreads();
    const XcdBarrier xbar = xcd_barrier_post((unsigned*)(prm.ws + OFF_BAR), bst);
    const int lo = prm.lo, hi = prm.hi;
#define IN(k) (ON((k) >= 14 && (k) <= 18 ? (k) - 8 : (k)) && lo <= (k) && (k) < hi)
#define SYNC(k) do { if (lo <= (k) && (k) + 1 < hi) xcd_barrier(xbar); } while (0)
    if (lo < 0) grid.sync();
#define XATTN_MLP(l, pb) \
    if (IN(pb)) REPS(pb) { EpiNormBf16<0> E{SSQP, WSP(bf16_t, OFF_Q), DM, QSCALE}; run_gemm(c, XB, WSP(bf16_t, OFF_WQ) + (size_t)(l) * 1048576, 1024, 4, E); } SYNC(pb); \
    if (IN(pb + 1)) REPS(pb + 1) { phase_attn(c, l, rep_ ? PROBE_AMASK : 3); } SYNC(pb + 1); \
    if (IN(pb + 2)) { EpiRes E{false, nullptr, nullptr, XB, SSQP}; run_gemm(c, WSP(bf16_t, OFF_OAT), WSP(bf16_t, OFF_WO) + (size_t)(l) * 1048576, 1024, 4, E); } SYNC(pb + 2); \
    if (IN(pb + 3)) REPS(pb + 3) { EpiNormBf16<1> E{SSQP, WSP(bf16_t, OFF_U), DFF, 1.0f}; run_gemm(c, XB, WSP(bf16_t, OFF_WUP) + (size_t)(l) * 4194304, 1024, 16, E, false, pb + 3); } SYNC(pb + 3); \
    if (IN(pb + 4)) { EpiRes E{false, nullptr, nullptr, XB, SSQP}; run_gemm(c, WSP(bf16_t, OFF_U), WSP(bf16_t, OFF_WDN) + (size_t)(l) * 4194304, 4096, 4, E); } SYNC(pb + 4);
    if (IN(0)) REPS(0) { phase_prologue(c); } SYNC(0);
    if (IN(1)) REPS(1) { EpiInMem E{SSQP, WSP(float, OFF_MSSQ), WSP(bf16_t, OFF_Z), c.out, WSP(bf16_t, OFF_KB), WSP(bf16_t, OFF_VT)}; run_gemm(c, XB, WSP(bf16_t, OFF_WA), 1024, 9, E, true, 1); } SYNC(1);
    if (IN(2)) REPS(2) { phase_pool_prep(c); } SYNC(2);
    if (IN(3)) REPS(3) { phase_scan(c); } SYNC(3);
    if (IN(4)) REPS(4) { phase_post(c); } SYNC(4);
    if (IN(5)) { EpiRes E{true, c.in[0], c.in[1], XB, SSQP}; run_gemm(c, WSP(bf16_t, OFF_CAT), WSP(bf16_t, OFF_WOAB), 1024, 4, E, false, 5); } SYNC(5);
    XATTN_MLP(0, 6)
    if (IN(11)) REPS(11) { EpiGelu E{SSQP, WSP(bf16_t, OFF_U2), WSP(bf16_t, OFF_VPRE), WSP(float, OFF_LNP)}; run_gemm(c, XB, WSP(bf16_t, OFF_WINC), 1024, 16, E, false, 11); } SYNC(11);
    if (IN(12)) REPS(12) { phase_spatial(c); } SYNC(12);
    if (IN(13)) { EpiRes E{false, nullptr, nullptr, XB, SSQP}; run_gemm(c, WSP(bf16_t, OFF_G2), WSP(bf16_t, OFF_WOUTC), 2048, 4, E); } SYNC(13);
    XATTN_MLP(1, 14)
    if (IN(19)) { phase_final(c); }
#undef IN
#undef SYNC
}

#ifndef MK_MULTI
#define MK_MULTI 0
#endif
extern "C" void kernel_launch(void* const* d_in, const int* in_sizes, int n_in, void* d_out, int out_size, void* d_ws, size_t ws_size, hipStream_t stream) {
    static int grid = 0;
    if (grid == 0) {
        int dev = 0, cus = 0, per_cu = 0;
        if (n_in != 40 || ws_size < OFF_END) { fprintf(stderr, "kernel_launch: unexpected n_in %d / ws_size %zu (need %zu)\n", n_in, ws_size, (size_t)OFF_END); grid = -1; return; }
        (void)hipGetDevice(&dev); (void)hipDeviceGetAttribute(&cus, hipDeviceAttributeMultiprocessorCount, dev);
        if (hipFuncSetAttribute((const void*)mega_fwd, hipFuncAttributeMaxDynamicSharedMemorySize, LDS_BYTES) != hipSuccess) { fprintf(stderr, "kernel_launch: hipFuncSetAttribute failed\n"); grid = -1; return; }
        if (hipOccupancyMaxActiveBlocksPerMultiprocessor(&per_cu, (const void*)mega_fwd, 512, LDS_BYTES) != hipSuccess || per_cu < 1) { fprintf(stderr, "kernel_launch: occupancy query says %d blocks per CU\n", per_cu); grid = -1; (void)hipGetLastError(); return; }
        grid = cus;
    }
    if (grid < 0) return;
    if (hipMemsetAsync((char*)d_ws + OFF_BAR, 0, XCD_BAR_WORDS * 4, stream) != hipSuccess) { fprintf(stderr, "kernel_launch: memset failed\n"); return; }
    Params p{};
    for (int i = 0; i < 40; ++i) p.in[i] = (const float*)d_in[i];
    p.out = (float*)d_out; p.ws = (unsigned char*)d_ws;
#if MK_MULTI
    for (int ph = 0; ph < NPHASE; ++ph) { p.lo = ph; p.hi = ph + 1; hipLaunchKernelGGL(mega_fwd, dim3(grid), dim3(512), LDS_BYTES, stream, p); }
#else
    p.lo = 0; p.hi = NPHASE;
    void* args[] = {&p};
    hipError_t e = hipLaunchCooperativeKernel((const void*)mega_fwd, dim3(grid), dim3(512), args, LDS_BYTES, stream);
    if (e != hipSuccess) fprintf(stderr, "cooperative launch failed: %s (grid %d)\n", hipGetErrorString(e), grid);
#endif
}
```
